# Optimizing an MI355X kernel written in HIP

```python
import jax, jax.numpy as jnp
from jax import lax
import numpy as np

D_MODEL = 1024
BATCH = 8
SEQ = 4096
DEPTH = 1

D_MIX = D_MODEL
SB_HEADS = 8
HEAD_DIM = 64
SB_WIDTH = SB_HEADS * HEAD_DIM
LRU_WIDTH = D_MIX - SB_WIDTH
LRU_BLOCKS = 8
LRU_BLOCK_DIM = LRU_WIDTH // LRU_BLOCKS
CONV_WIDTH = 4
LRU_C = 8.0
D_IN = 3 * SB_WIDTH + 2 * LRU_WIDTH
Q_BLOCK = 128
N_EXPERTS = 32
TOP_K = 4
D_EXPERT = D_MODEL
SWIGLU_LIMIT = 7.0
SWIGLU_ALPHA = 1.702
EXPERT_BLOCK = 256
EPS = 1e-6
N_MOD = 6

kernel_name = "hymba_stickbreak_rglru_moe_adaln"


def rmsnorm(x, g):
    x32 = x.astype(jnp.float32)
    y = x32 * lax.rsqrt(jnp.mean(x32 * x32, axis=-1, keepdims=True) + EPS)
    return (y * g.astype(jnp.float32)).astype(x.dtype)


def modulate(h, shift, scale):
    return h * (1.0 + scale[:, None, :]) + shift[:, None, :]


def stick_breaking_attention(q, k, v):
    B, S, H, Dh = q.shape
    n_blocks = S // Q_BLOCK
    qh = jnp.transpose(q, (0, 2, 1, 3)).astype(jnp.float32) * (Dh ** -0.5)
    kh = jnp.transpose(k, (0, 2, 1, 3)).astype(jnp.float32)
    vh = jnp.transpose(v, (0, 2, 1, 3)).astype(jnp.float32)
    k_pos = jnp.arange(S)

    def one_block(i):
        q_blk = lax.dynamic_slice_in_dim(qh, i * Q_BLOCK, Q_BLOCK, axis=2)
        z = jnp.einsum('bhqd,bhkd->bhqk', q_blk, kh)
        q_pos = i * Q_BLOCK + jnp.arange(Q_BLOCK)
        causal = k_pos[None, :] < q_pos[:, None]
        log_beta = jax.nn.log_sigmoid(z)
        log_keep = jnp.where(causal, log_beta - z, 0.0)
        later = lax.cumsum(log_keep, axis=3, reverse=True) - log_keep
        weights = jnp.where(causal, jnp.exp(log_beta + later), 0.0)
        return jnp.einsum('bhqk,bhkd->bhqd', weights, vh)

    out = lax.map(one_block, jnp.arange(n_blocks))
    out = jnp.transpose(out, (1, 0, 3, 2, 4)).reshape(B, S, H * Dh)
    return out.astype(q.dtype)


def rg_lru_branch(xr, gr, conv_w, conv_b, rg_w, rg_b, ig_w, ig_b, lru_lambda):
    B, S, W = xr.shape
    x32 = xr.astype(jnp.float32)
    xp = jnp.pad(x32, ((0, 0), (CONV_WIDTH - 1, 0), (0, 0)))
    cw = conv_w.astype(jnp.float32)
    xc = conv_b.astype(jnp.float32) + sum(cw[j] * xp[:, j:j + S] for j in range(CONV_WIDTH))
    xh = xc.reshape(B, S, LRU_BLOCKS, LRU_BLOCK_DIM)
    r = jax.nn.sigmoid(jnp.einsum('bshi,hij->bshj', xh, rg_w.astype(jnp.float32)).reshape(B, S, W)
                       + rg_b.astype(jnp.float32))
    ig = jax.nn.sigmoid(jnp.einsum('bshi,hij->bshj', xh, ig_w.astype(jnp.float32)).reshape(B, S, W)
                        + ig_b.astype(jnp.float32))
    log_a = -LRU_C * r * jax.nn.softplus(-lru_lambda.astype(jnp.float32))
    a = jnp.exp(log_a)
    b = jnp.sqrt(-jnp.expm1(2.0 * log_a)) * (ig * xc)

    def combine(left, right):
        a1, b1 = left
        a2, b2 = right
        return a1 * a2, a2 * b1 + b2

    _, h = lax.associative_scan(combine, (a, b), axis=1)
    y = h * jax.nn.gelu(gr.astype(jnp.float32))
    return y.astype(xr.dtype)


def hybrid_mixer(h, w_in, conv_w, conv_b, rg_w, rg_b, ig_w, ig_b, lru_lambda,
                 attn_out_g, lru_out_g, w_out):
    B, S, _ = h.shape
    proj = jnp.einsum('bsd,de->bse', h, w_in)
    q, k, v, xr, gr = jnp.split(
        proj, [SB_WIDTH, 2 * SB_WIDTH, 3 * SB_WIDTH, 3 * SB_WIDTH + LRU_WIDTH], axis=-1)
    q = q.reshape(B, S, SB_HEADS, HEAD_DIM)
    k = k.reshape(B, S, SB_HEADS, HEAD_DIM)
    v = v.reshape(B, S, SB_HEADS, HEAD_DIM)
    y_attn = stick_breaking_attention(q, k, v)
    y_lru = rg_lru_branch(xr, gr, conv_w, conv_b, rg_w, rg_b, ig_w, ig_b, lru_lambda)
    y = jnp.concatenate([rmsnorm(y_attn, attn_out_g), rmsnorm(y_lru, lru_out_g)], axis=-1)
    return jnp.einsum('bse,ed->bsd', y, w_out)


def moe_ffn(h, router_w, router_b, w_gate, b_gate, w_up, b_up, w_down, b_down):
    B, S, D = h.shape
    N = B * S
    xf = h.reshape(N, D)
    logits = xf.astype(jnp.float32) @ router_w.astype(jnp.float32) + router_b.astype(jnp.float32)
    top_val, top_idx = lax.top_k(logits, TOP_K)
    probs = jax.nn.softmax(top_val, axis=-1)
    n_assign = N * TOP_K
    flat_e = top_idx.reshape(-1).astype(jnp.int32)
    order = jnp.argsort(flat_e)
    e_sorted = flat_e[order]
    tok_sorted = (order // TOP_K).astype(jnp.int32)
    p_sorted = probs.reshape(-1)[order]
    counts = jnp.bincount(flat_e, length=N_EXPERTS).astype(jnp.int32)
    starts = jnp.cumsum(counts) - counts
    padded = ((counts + EXPERT_BLOCK - 1) // EXPERT_BLOCK) * EXPERT_BLOCK
    pad_ends = jnp.cumsum(padded)
    pad_starts = pad_ends - padded
    dest = pad_starts[e_sorted] + (jnp.arange(n_assign, dtype=jnp.int32) - starts[e_sorted])
    n_blocks = -(-n_assign // EXPERT_BLOCK) + N_EXPERTS
    cap = n_blocks * EXPERT_BLOCK
    tok_buf = jnp.zeros((cap,), jnp.int32).at[dest].set(tok_sorted)
    p_buf = jnp.zeros((cap,), jnp.float32).at[dest].set(p_sorted)
    block_start = jnp.arange(n_blocks, dtype=jnp.int32) * EXPERT_BLOCK
    block_e = jnp.minimum(jnp.searchsorted(pad_ends, block_start, side='right'),
                          N_EXPERTS - 1).astype(jnp.int32)

    def expert_block(args):
        tok, e = args
        xb = xf[tok]
        g = jnp.minimum(xb @ w_gate[e] + b_gate[e], SWIGLU_LIMIT)
        u = jnp.clip(xb @ w_up[e] + b_up[e], -SWIGLU_LIMIT, SWIGLU_LIMIT)
        act = (u + 1.0) * (g * jax.nn.sigmoid(SWIGLU_ALPHA * g))
        return act @ w_down[e] + b_down[e]

    y_blocks = lax.map(expert_block, (tok_buf.reshape(n_blocks, EXPERT_BLOCK), block_e))
    y = y_blocks.reshape(cap, D).astype(jnp.float32) * p_buf[:, None]
    out = jax.ops.segment_sum(y, tok_buf, num_segments=N)
    return out.reshape(B, S, D).astype(h.dtype)


def setup_inputs(seed: int = 0) -> dict:
    key = jax.random.key(seed)
    ks = jax.random.split(key, 32)

    def nrm(k, shape, scale):
        return jax.random.normal(k, shape, jnp.float32) * scale

    a_pow = jax.random.uniform(ks[12], (DEPTH, LRU_WIDTH), jnp.float32, 0.9, 0.999)
    a_base = a_pow ** (1.0 / LRU_C)
    return {
        "x": nrm(ks[0], (BATCH, SEQ, D_MODEL), 1.0),
        "c": nrm(ks[1], (BATCH, D_MODEL), 1.0),
        "ada_w": nrm(ks[2], (DEPTH, D_MODEL, N_MOD * D_MODEL), D_MODEL ** -0.5),
        "ada_b": nrm(ks[3], (DEPTH, N_MOD * D_MODEL), 0.02),
        "mix_norm_g": 1.0 + nrm(ks[4], (DEPTH, D_MODEL), 0.02),
        "w_in": nrm(ks[5], (DEPTH, D_MODEL, D_IN), D_MODEL ** -0.5),
        "conv_w": nrm(ks[6], (DEPTH, CONV_WIDTH, LRU_WIDTH), CONV_WIDTH ** -0.5),
        "conv_b": nrm(ks[7], (DEPTH, LRU_WIDTH), 0.02),
        "rg_w": nrm(ks[8], (DEPTH, LRU_BLOCKS, LRU_BLOCK_DIM, LRU_BLOCK_DIM), LRU_BLOCK_DIM ** -0.5),
        "rg_b": nrm(ks[9], (DEPTH, LRU_WIDTH), 0.02),
        "ig_w": nrm(ks[10], (DEPTH, LRU_BLOCKS, LRU_BLOCK_DIM, LRU_BLOCK_DIM), LRU_BLOCK_DIM ** -0.5),
        "ig_b": nrm(ks[11], (DEPTH, LRU_WIDTH), 0.02),
        "lru_lambda": jnp.log(a_base) - jnp.log1p(-a_base),
        "attn_out_g": 1.0 + nrm(ks[13], (DEPTH, SB_WIDTH), 0.02),
        "lru_out_g": 1.0 + nrm(ks[14], (DEPTH, LRU_WIDTH), 0.02),
        "w_out": nrm(ks[15], (DEPTH, D_MIX, D_MODEL), D_MIX ** -0.5),
        "ffn_norm_g": 1.0 + nrm(ks[16], (DEPTH, D_MODEL), 0.02),
        "router_w": nrm(ks[17], (DEPTH, D_MODEL, N_EXPERTS), D_MODEL ** -0.5),
        "router_b": nrm(ks[18], (DEPTH, N_EXPERTS), 0.01),
        "exp_w_gate": nrm(ks[19], (DEPTH, N_EXPERTS, D_MODEL, D_EXPERT), D_MODEL ** -0.5),
        "exp_b_gate": nrm(ks[20], (DEPTH, N_EXPERTS, D_EXPERT), 0.02),
        "exp_w_up": nrm(ks[21], (DEPTH, N_EXPERTS, D_MODEL, D_EXPERT), D_MODEL ** -0.5),
        "exp_b_up": nrm(ks[22], (DEPTH, N_EXPERTS, D_EXPERT), 0.02),
        "exp_w_down": nrm(ks[23], (DEPTH, N_EXPERTS, D_EXPERT, D_MODEL), D_EXPERT ** -0.5),
        "exp_b_down": nrm(ks[24], (DEPTH, N_EXPERTS, D_MODEL), 0.02),
        "final_norm_g": 1.0 + nrm(ks[25], (D_MODEL,), 0.02),
    }


def reference(x, c, ada_w, ada_b, mix_norm_g, w_in, conv_w, conv_b, rg_w, rg_b, ig_w, ig_b,
              lru_lambda, attn_out_g, lru_out_g, w_out, ffn_norm_g, router_w, router_b,
              exp_w_gate, exp_b_gate, exp_w_up, exp_b_up, exp_w_down, exp_b_down, final_norm_g):
    c_act = jax.nn.silu(c)
    for l in range(DEPTH):
        mod = jnp.einsum('bd,de->be', c_act, ada_w[l]) + ada_b[l]
        sh_m, sc_m, g_m, sh_f, sc_f, g_f = jnp.split(mod, N_MOD, axis=-1)
        h = modulate(rmsnorm(x, mix_norm_g[l]), sh_m, sc_m)
        x = x + g_m[:, None, :] * hybrid_mixer(
            h, w_in[l], conv_w[l], conv_b[l], rg_w[l], rg_b[l], ig_w[l], ig_b[l],
            lru_lambda[l], attn_out_g[l], lru_out_g[l], w_out[l])
        h = modulate(rmsnorm(x, ffn_norm_g[l]), sh_f, sc_f)
        x = x + g_f[:, None, :] * moe_ffn(
            h, router_w[l], router_b[l], exp_w_gate[l], exp_b_gate[l], exp_w_up[l], exp_b_up[l],
            exp_w_down[l], exp_b_down[l])
    return rmsnorm(x, final_norm_g)
```

```cpp
#include <hip/hip_runtime.h>
#include <cstdio>
#include <cstdint>

constexpr int BATCH = 8, SEQ = 4096, DM = 1024, NTOK = BATCH * SEQ;
constexpr int DIN = 2560, SBW = 512, LRW = 512, NH = 8, HD = 64;
constexpr int NE = 32, TOPK = 4, NASG = NTOK * TOPK, DE = 1024;
constexpr float EPS = 1e-6f;
constexpr float C2 = 0.125f * 1.4426950408889634f;
constexpr float LN2 = 0.6931471805599453f;

constexpr size_t MiB = 1u << 20;
constexpr size_t WS_CTL = 0, CTL_ZERO_BYTES = 1 * MiB;
constexpr size_t WS_MOD = 1 * MiB;
constexpr size_t WS_WR = 1 * MiB + 256 * 1024;
constexpr size_t WS_PASG = 1 * MiB + 512 * 1024;
constexpr size_t WS_SSA = 2 * MiB;
constexpr size_t WS_SSL = 3 * MiB;
constexpr size_t WS_SSX = 7 * MiB;
constexpr size_t WS_LIST = 9 * MiB;
constexpr size_t WS_RA = 18 * MiB;
constexpr size_t WS_XN = WS_RA, WS_PROJ = WS_RA + 64 * MiB, WS_WINT = WS_RA + 224 * MiB, WS_WOUTT = WS_RA + 229 * MiB, WS_ACT = WS_RA;
constexpr size_t WS_RB = WS_RA + 256 * MiB;
constexpr size_t WS_WGU = WS_RB;
constexpr size_t WS_WDT = WS_RB + 128 * MiB;
constexpr size_t WS_X1B = WS_WDT + 64 * MiB;
constexpr size_t WS_END = WS_X1B + 64 * MiB;
constexpr size_t PROJ_STRIDE = (size_t)NTOK * 512;
constexpr size_t DO_Y = 0, DO_H2 = 64 * MiB;
constexpr int CW_CNT = 64;
constexpr int CW_BAR = 4096;

typedef unsigned short bf16;
typedef unsigned u32x4 __attribute__((ext_vector_type(4)));
typedef float f32x4 __attribute__((ext_vector_type(4)));

__device__ __forceinline__ float bf2f(bf16 v) { return __uint_as_float((unsigned)v << 16); }
__device__ __forceinline__ unsigned f2bf(float f) { unsigned u = __float_as_uint(f); return (u + 0x7fffu + ((u >> 16) & 1u)) >> 16; }
__device__ __forceinline__ unsigned pk2(float lo, float hi) { return f2bf(lo) | (f2bf(hi) << 16); }
__device__ __forceinline__ unsigned pk4_fp8(float a, float b, float c, float d) {
    a = fminf(fmaxf(a, -448.f), 448.f); b = fminf(fmaxf(b, -448.f), 448.f); c = fminf(fmaxf(c, -448.f), 448.f); d = fminf(fmaxf(d, -448.f), 448.f);
    int r = 0; r = __builtin_amdgcn_cvt_pk_fp8_f32(a, b, r, false); r = __builtin_amdgcn_cvt_pk_fp8_f32(c, d, r, true); return (unsigned)r; }
__device__ __forceinline__ unsigned pk4_fp8_raw(float a, float b, float c, float d) {
    int r = 0; r = __builtin_amdgcn_cvt_pk_fp8_f32(a, b, r, false); r = __builtin_amdgcn_cvt_pk_fp8_f32(c, d, r, true); return (unsigned)r; }
__device__ __forceinline__ unsigned pk4_fp8_m3(float a, float b, float c, float d) {
    a = __builtin_amdgcn_fmed3f(a, -448.f, 448.f); b = __builtin_amdgcn_fmed3f(b, -448.f, 448.f); c = __builtin_amdgcn_fmed3f(c, -448.f, 448.f); d = __builtin_amdgcn_fmed3f(d, -448.f, 448.f);
    int r = 0; r = __builtin_amdgcn_cvt_pk_fp8_f32(a, b, r, false); r = __builtin_amdgcn_cvt_pk_fp8_f32(c, d, r, true); return (unsigned)r; }
constexpr float W8_SCALE = 1.f;
__device__ __forceinline__ float sigmoidf_(float x) { return 1.f / (1.f + __expf(-x)); }
__device__ __forceinline__ float gelu_tanh(float x) { const float u = 0.7978845608028654f * (x + 0.044715f * x * x * x); return 0.5f * x * (1.f + tanhf(u)); }
__device__ __forceinline__ void unpack8(const u32x4 v, float* f) {
    f[0] = __uint_as_float(v.x << 16); f[1] = __uint_as_float(v.x & 0xffff0000u); f[2] = __uint_as_float(v.y << 16); f[3] = __uint_as_float(v.y & 0xffff0000u);
    f[4] = __uint_as_float(v.z << 16); f[5] = __uint_as_float(v.z & 0xffff0000u); f[6] = __uint_as_float(v.w << 16); f[7] = __uint_as_float(v.w & 0xffff0000u);
}
__device__ __forceinline__ float dot8(const u32x4 a, const u32x4 b) {
    float x[8], y[8]; unpack8(a, x); unpack8(b, y); float s = 0.f;
#pragma unroll
    for (int i = 0; i < 8; ++i) s += x[i] * y[i];
    return s;
}

#if defined(__HIP_DEVICE_COMPILE__)
#define KGAS __attribute__((address_space(1)))
#else
#define KGAS
#endif
struct Args {
    KGAS const float* in[26]; KGAS float* out; KGAS unsigned char* ws; int ph_lo, ph_hi, li, pad;
    __host__ __device__ __forceinline__ const float* inp(int i) const { return (const float*)in[i]; }
    __host__ __device__ __forceinline__ float* outp() const { return (float*)out; }
    __host__ __device__ __forceinline__ unsigned char* wsp() const { return (unsigned char*)ws; }
};
enum { I_X = 0, I_C, I_ADAW, I_ADAB, I_MIXG, I_WIN, I_CONVW, I_CONVB, I_RGW, I_RGB, I_IGW, I_IGB, I_LAMBDA, I_AOG, I_LOG, I_WOUT, I_FFNG, I_RW, I_RB, I_WG, I_BG, I_WU, I_BU, I_WD, I_BD, I_FING };

#define GAS __attribute__((address_space(1)))
#define LAS __attribute__((address_space(3)))
typedef GAS unsigned gu32;
#define RLX_AGENT __ATOMIC_RELAXED, __HIP_MEMORY_SCOPE_AGENT
#define LDS_WAIT() asm volatile("s_waitcnt lgkmcnt(0)" ::: "memory")
#define VM_WAIT() asm volatile("s_waitcnt vmcnt(0)" ::: "memory")
constexpr int NWAVES = 8;
constexpr int RING_BYTES = 131072, TAB_OFF = RING_BYTES, LDS_BYTES = 161792, LDSCTL_OFF = LDS_BYTES - 512, MISC_OFF = LDSCTL_OFF + 320, BIAS_OFF = LDSCTL_OFF - 2048;

#define XB_TMO      128
#define XB_XCNT(j)  (256  + 64 * (j))
#define XB_XSUB(j)  (1280 + 64 * (j))
#define XB_XGEN(j)  (2304 + 64 * (j))
#define XB_TOP      3328
#define XB_TOPGEN   3392
#define XCD_BAR_WORDS 3456
#define XB_SPIN_CAP (1u << 18)
__device__ __forceinline__ unsigned xb_ld(unsigned* p)              { return __hip_atomic_load(p, __ATOMIC_RELAXED, __HIP_MEMORY_SCOPE_AGENT); }
__device__ __forceinline__ unsigned xb_add(unsigned* p, unsigned v) { return __hip_atomic_fetch_add(p, v, __ATOMIC_RELAXED, __HIP_MEMORY_SCOPE_AGENT); }
__device__ __forceinline__ unsigned xb_xcc_id() { return (unsigned)__builtin_amdgcn_s_getreg((3 << 11) | 20) & 0xFu; }
#define XB_SPIN(cond, bar) do { unsigned _sp = 0; while (cond) { __builtin_amdgcn_s_sleep(1); \
    if ((++_sp & 255u) == 0u) { if (xb_ld(&(bar)[XB_TMO])) break; if (_sp > XB_SPIN_CAP) { atomicAdd(&(bar)[XB_TMO], 1u); break; } } } } while (0)
struct XcdBarrier { unsigned* bar; unsigned x; volatile LAS unsigned* st; };
__device__ __forceinline__ XcdBarrier xcd_barrier_post(unsigned* bar, volatile LAS unsigned* st) {
    XcdBarrier b; b.bar = bar; b.x = xb_xcc_id(); b.st = st;
    if (threadIdx.x == 0) (void)xb_add(&bar[XB_XCNT(b.x)], 1u);
    return b;
}
__device__ __forceinline__ void xcd_barrier_complete(unsigned* bar, unsigned x, unsigned& nloc, unsigned& nx) {
    const unsigned G = gridDim.x * gridDim.y * gridDim.z;
    unsigned sum, cnt, mine, sp = 0u;
    for (;;) {
        sum = 0u; cnt = 0u; mine = 0u;
#pragma unroll
        for (unsigned j = 0; j < 16; ++j) { const unsigned c = xb_ld(&bar[XB_XCNT(j)]); sum += c; cnt += (c > 0u) ? 1u : 0u; mine = (j == x) ? c : mine; }
        if (sum == G) break;
        __builtin_amdgcn_s_sleep(1);
        if ((++sp & 255u) == 0u) { if (xb_ld(&bar[XB_TMO])) break; if (sp > XB_SPIN_CAP) { atomicAdd(&bar[XB_TMO], 1u); break; } }
    }
    nloc = mine > 0u ? mine : 1u; nx = cnt > 0u ? cnt : 1u;
}
__device__ __forceinline__ int lane_id();
__device__ __forceinline__ void xcd_barrier(const XcdBarrier& b, const int wave_) {
    asm volatile("s_waitcnt vmcnt(0)" ::: "memory");
    __syncthreads();
    if (wave_ == 0 && lane_id() == 0) {
        unsigned* bar = b.bar;
        __builtin_amdgcn_s_waitcnt(0);
        unsigned nloc = b.st[0], nx = b.st[1];
        if (nloc == 0u) { xcd_barrier_complete(bar, b.x, nloc, nx); b.st[0] = nloc; b.st[1] = nx; }
        const unsigned old = xb_add(&bar[XB_XSUB(b.x)], 1u);
        const unsigned gen = old / nloc;
        if (old + 1u == (gen + 1u) * nloc) {
            __builtin_amdgcn_fence(__ATOMIC_RELEASE, "agent");
            asm volatile("s_waitcnt vmcnt(0)" ::: "memory");
            const unsigned og = xb_add(&bar[XB_TOP], 1u);
            const unsigned tg = og / nx;
            if (og + 1u == (tg + 1u) * nx) xb_add(&bar[XB_TOPGEN], 1u);
            else XB_SPIN(xb_ld(&bar[XB_TOPGEN]) == tg, bar);
            __builtin_amdgcn_fence(__ATOMIC_ACQUIRE, "agent");
            xb_add(&bar[XB_XGEN(b.x)], 1u);
            asm volatile("s_waitcnt vmcnt(0)" ::: "memory");
        } else {
            XB_SPIN(xb_ld(&bar[XB_XGEN(b.x)]) == gen, bar);
            __builtin_amdgcn_fence(__ATOMIC_ACQUIRE, "agent");
            asm volatile("s_waitcnt vmcnt(0)" ::: "memory");
        }
    }
    __syncthreads();
}

__device__ __forceinline__ int lane_id() { int r; asm volatile("v_mbcnt_lo_u32_b32 %0, -1, 0\n\tv_mbcnt_hi_u32_b32 %0, -1, %0" : "=v"(r)); return r; }
__device__ __forceinline__ float wave_sum(float v) {
#pragma unroll
    for (int o = 1; o < 64; o <<= 1) v += __shfl_xor(v, o);
    return v;
}

__device__ __forceinline__ void p0_adaln(const Args& a, LAS unsigned char* lds, int tid, int G) {
    LAS float* cact = (LAS float*)lds;
    LAS float* part = (LAS float*)(lds + 32768);
    const float* c = a.inp(I_C);
    for (int i = tid; i < 8 * 1024; i += 512) { const int b = i >> 10, k = i & 1023; const float v = c[i]; cact[k * 8 + b] = v / (1.f + __expf(-v)); }
    __syncthreads();
    const float* W = a.inp(I_ADAW); float* mod = (float*)(a.wsp() + WS_MOD);
    const int col = tid % 24, ks = tid / 24;
    for (int ch = blockIdx.x; ch < 6144 / 24; ch += G) {
        const int n = ch * 24 + col;
        if (ks < 21) {
            float acc[8];
#pragma unroll
            for (int b = 0; b < 8; ++b) acc[b] = 0.f;
#pragma unroll 7
            for (int k = ks; k < 1024; k += 21) {
                const float w = W[(size_t)k * 6144 + n];
                const f32x4 c0 = *(const LAS f32x4*)(cact + k * 8), c1 = *(const LAS f32x4*)(cact + k * 8 + 4);
                acc[0] += w * c0.x; acc[1] += w * c0.y; acc[2] += w * c0.z; acc[3] += w * c0.w;
                acc[4] += w * c1.x; acc[5] += w * c1.y; acc[6] += w * c1.z; acc[7] += w * c1.w;
            }
#pragma unroll
            for (int b = 0; b < 8; ++b) part[(ks * 24 + col) * 8 + b] = acc[b];
        }
        __syncthreads();
        if (tid < 192) { const int cc = tid >> 3, b = tid & 7; float s = a.inp(I_ADAB)[ch * 24 + cc];
            for (int q = 0; q < 21; ++q) s += part[(q * 24 + cc) * 8 + b];
            mod[b * 6144 + ch * 24 + cc] = s; }
        __syncthreads();
    }
}

struct P1Item { const float* W; const float* ks; unsigned char* dst; int N, k0, n0, e8, which, fp8; };
__device__ __forceinline__ P1Item p1_decode(const Args& a, int it) {
    constexpr int I_IN = 16 * (DIN / 256), I_OUT = 16 * 4, I_EXP = 8 * 4;
    P1Item d; d.ks = nullptr; d.fp8 = 0; d.e8 = 0; d.which = 0;
    if (it < I_IN) { const int nb = DIN / 256; d.W = a.inp(I_WIN); d.N = DIN; d.k0 = 64 * (it / nb); d.n0 = 256 * (it % nb); d.dst = a.wsp() + WS_WINT; return d; }
    it -= I_IN;
    if (it < I_OUT) { d.W = a.inp(I_WOUT); d.N = DM; d.k0 = 64 * (it / 4); d.n0 = 256 * (it % 4); d.dst = a.wsp() + WS_WOUTT;
        d.ks = (d.k0 < 512) ? a.inp(I_AOG) : (a.inp(I_LOG) - 512); return d; }
    it -= I_OUT;
    const int mat = it / I_EXP, q = it % I_EXP, e = mat / 3; d.which = mat % 3;
    d.k0 = 128 * (q / 4); d.n0 = 256 * (q % 4); d.fp8 = 1; d.N = 1024; d.e8 = e;
    if (d.which == 2) { d.W = a.inp(I_WD) + (size_t)e * DE * DM; d.dst = a.wsp() + WS_WDT; }
    else { d.W = a.inp(d.which == 0 ? I_WG : I_WU) + (size_t)e * DM * DE; d.dst = a.wsp() + WS_WGU; }
    return d;
}
__device__ __forceinline__ void p1_prep(const Args& a, LAS unsigned char* lds, int tid, int lane, int wave, int vcu, int G) {
    constexpr int NIT = 16 * (DIN / 256) + 16 * 4 + 96 * 8 * 4;
    const int col4 = (tid & 63) * 4, rb = tid >> 6;
    f32x4 tv[16];
    P1Item cur = p1_decode(a, (int)blockIdx.x < NIT ? (int)blockIdx.x : 0);
#define P1_LOAD(d) do { _Pragma("unroll") for (int i = 0; i < 16; ++i) { int kk_ = (d).k0 + rb + 8 * i; kk_ = kk_ < 1023 ? kk_ : 1023;     \
        tv[i] = *(const f32x4*)((d).W + (size_t)kk_ * (d).N + (d).n0 + col4); } } while (0)
    if ((int)blockIdx.x < NIT) P1_LOAD(cur);
    int buf = 0;
    for (int it = blockIdx.x; it < NIT; it += G) {
        LAS unsigned char* T = lds + buf * 32768;
        if (cur.fp8) {
#pragma unroll
            for (int i = 0; i < 16; ++i) *(LAS unsigned*)(T + (rb + 8 * i) * 256 + col4) = pk4_fp8(tv[i].x * W8_SCALE, tv[i].y * W8_SCALE, tv[i].z * W8_SCALE, tv[i].w * W8_SCALE);
        } else {
#pragma unroll
            for (int i = 0; i < 8; ++i) { f32x4 v = tv[i]; if (cur.ks) v = v * cur.ks[cur.k0 + rb + 8 * i];
                typedef unsigned u32x2 __attribute__((ext_vector_type(2))); *(LAS u32x2*)(T + (rb + 8 * i) * 512 + col4 * 2) = (u32x2){pk2(v.x, v.y), pk2(v.z, v.w)}; }
        }
        const P1Item me = cur;
        const int itn = it + G;
        if (itn < NIT) { cur = p1_decode(a, itn); P1_LOAD(cur); }
        __syncthreads();
        { const int n = tid & 255, hf = tid >> 8, ng = me.n0 + n;
          u32x4 o[4];
          if (me.fp8) {
#pragma unroll
              for (int q = 0; q < 4; ++q) { unsigned w4[4];
#pragma unroll
                  for (int r = 0; r < 4; ++r) { const LAS unsigned char* p = T + (hf * 64 + q * 16 + r * 4) * 256 + n;
                      w4[r] = (unsigned)p[0] | ((unsigned)p[256] << 8) | ((unsigned)p[512] << 16) | ((unsigned)p[768] << 24); }
                  o[q] = (u32x4){w4[0], w4[1], w4[2], w4[3]}; }
              const size_t orow = (me.which == 2) ? (size_t)me.e8 * DM + ng : (size_t)(me.e8 * 8 + ng / 128) * 256 + (ng % 128) + (me.which ? 128 : 0);
              u32x4* dp = (u32x4*)(me.dst + orow * DM + me.k0 + hf * 64);
#pragma unroll
              for (int q = 0; q < 4; ++q) dp[q] = o[q];
          } else {
#pragma unroll
              for (int q = 0; q < 4; ++q) { unsigned w4[4];
#pragma unroll
                  for (int r = 0; r < 4; ++r) { const LAS unsigned short* p = (const LAS unsigned short*)(T + (hf * 32 + q * 8 + r * 2) * 512 + n * 2);
                      w4[r] = (unsigned)p[0] | ((unsigned)p[256] << 16); }
                  o[q] = (u32x4){w4[0], w4[1], w4[2], w4[3]}; }
              u32x4* dp = (u32x4*)((bf16*)me.dst + (size_t)ng * DM + me.k0 + hf * 32);
#pragma unroll
              for (int q = 0; q < 4; ++q) dp[q] = o[q];
          } }
        buf ^= 1;
    }
#undef P1_LOAD
    __syncthreads();
    const int gw = vcu * NWAVES + wave, NGW = G * NWAVES;
    { bf16* wr = (bf16*)(a.wsp() + WS_WR);
      for (int i = blockIdx.x * 512 + tid; i < 32 * 1024; i += G * 512) { const int e = i >> 10, k = i & 1023; const float w = a.inp(I_RW)[k * 32 + e];
          const unsigned hi = f2bf(w); wr[i] = (bf16)hi; wr[32768 + i] = (bf16)f2bf(w - __uint_as_float(hi << 16)); } }
    const float* mod = (const float*)(a.wsp() + WS_MOD);
    f32x4 v0[4], v1[4], w0[4], w1[4];
    if (gw < NTOK) {
#pragma unroll
        for (int j = 0; j < 4; ++j) { v0[j] = ((const f32x4*)(a.inp(I_X) + (size_t)gw * DM) + lane)[64 * j]; v1[j] = ((const f32x4*)(a.inp(I_X) + (size_t)(gw + NGW < NTOK ? gw + NGW : gw) * DM) + lane)[64 * j]; }
    }
    for (int m0 = gw; m0 < NTOK; m0 += 2 * NGW) {
        const int m1 = m0 + NGW; const bool two = m1 < NTOK;
        const int n0 = m0 + 2 * NGW, n1 = n0 + NGW;
        if (n0 < NTOK) {
#pragma unroll
            for (int j = 0; j < 4; ++j) { w0[j] = ((const f32x4*)(a.inp(I_X) + (size_t)n0 * DM) + lane)[64 * j]; w1[j] = ((const f32x4*)(a.inp(I_X) + (size_t)(n1 < NTOK ? n1 : n0) * DM) + lane)[64 * j]; }
        }
        float s0 = 0.f, s1 = 0.f;
#pragma unroll
        for (int j = 0; j < 4; ++j) { s0 += (v0[j].x * v0[j].x + v0[j].y * v0[j].y) + (v0[j].z * v0[j].z + v0[j].w * v0[j].w); s1 += (v1[j].x * v1[j].x + v1[j].y * v1[j].y) + (v1[j].z * v1[j].z + v1[j].w * v1[j].w); }
        const float rs0 = rsqrtf(wave_sum(s0) * (1.f / DM) + EPS), rs1 = rsqrtf(wave_sum(s1) * (1.f / DM) + EPS);
#pragma unroll
        for (int q = 0; q < 2; ++q) { if (q == 1 && !two) break;
            const int m = q ? m1 : m0; const int b = m / SEQ; const float rs = q ? rs1 : rs0;
            unsigned long long* o8 = (unsigned long long*)((bf16*)(a.wsp() + WS_XN) + (size_t)m * DM) + lane;
#pragma unroll
            for (int j = 0; j < 4; ++j) {
                const int k = 4 * lane + 256 * j;
                const f32x4 g = *(const f32x4*)(a.inp(I_MIXG) + k), sh = *(const f32x4*)(mod + b * 6144 + k), sc = *(const f32x4*)(mod + b * 6144 + 1024 + k);
                const f32x4 h = ((q ? v1[j] : v0[j]) * rs * g) * (sc + 1.f) + sh;
                o8[64 * j] = (unsigned long long)pk2(h.x, h.y) | ((unsigned long long)pk2(h.z, h.w) << 32);
            } }
#pragma unroll
        for (int j = 0; j < 4; ++j) { v0[j] = w0[j]; v1[j] = w1[j]; }
    }
}

__device__ __forceinline__ void p8_final(const Args& a, int lane, int wave, int vcu, int G) {
    typedef float f32x2 __attribute__((ext_vector_type(2)));
    const int gw = vcu * NWAVES + wave, NGW = G * NWAVES;
    const float* mod = (const float*)(a.wsp() + WS_MOD);
    u32x4 cx[2], cy[4], nx[2], ny[4];
#define P8_LOAD(m_, X, Y) do { const u32x4* x1_ = (const u32x4*)((const bf16*)(a.wsp() + WS_X1B) + (size_t)(m_) * DM) + 2 * lane; const u32x4* y_ = (const u32x4*)((const unsigned char*)a.outp() + (size_t)(m_) * 4096) + lane; \
        X[0] = x1_[0]; X[1] = x1_[1]; Y[0] = y_[0]; Y[1] = y_[64]; Y[2] = y_[128]; Y[3] = y_[192]; } while (0)
    if (gw < NTOK) P8_LOAD(gw, cx, cy);
    for (int m = gw; m < NTOK; m += NGW) {
        const int b = m / SEQ; const int mn = m + NGW;
        if (mn < NTOK) P8_LOAD(mn, nx, ny);
        float v[16], xv[16]; float s = 0.f;
        unpack8(cx[0], xv); unpack8(cx[1], xv + 8);
        const float* gp = mod + b * 6144 + 5120 + 16 * lane;
#pragma unroll
        for (int q = 0; q < 4; ++q) {
            const unsigned w0 = cy[0][q], w1 = cy[1][q], w2 = cy[2][q], w3 = cy[3][q];
            const f32x2 a0 = __builtin_amdgcn_cvt_pk_f32_fp8((int)w0, false), a1 = __builtin_amdgcn_cvt_pk_f32_fp8((int)w0, true), b0 = __builtin_amdgcn_cvt_pk_f32_fp8((int)w1, false), b1 = __builtin_amdgcn_cvt_pk_f32_fp8((int)w1, true);
            const f32x2 c0 = __builtin_amdgcn_cvt_pk_f32_fp8((int)w2, false), c1 = __builtin_amdgcn_cvt_pk_f32_fp8((int)w2, true), d0 = __builtin_amdgcn_cvt_pk_f32_fp8((int)w3, false), d1 = __builtin_amdgcn_cvt_pk_f32_fp8((int)w3, true);
            const f32x4 g = *(const f32x4*)(gp + 4 * q);
            const float y0 = (a0.x + b0.x) + (c0.x + d0.x), y1 = (a0.y + b0.y) + (c0.y + d0.y), y2 = (a1.x + b1.x) + (c1.x + d1.x), y3 = (a1.y + b1.y) + (c1.y + d1.y);
            const float t0 = xv[4 * q] + g.x * y0, t1 = xv[4 * q + 1] + g.y * y1, t2 = xv[4 * q + 2] + g.z * y2, t3 = xv[4 * q + 3] + g.w * y3;
            v[4 * q] = t0; v[4 * q + 1] = t1; v[4 * q + 2] = t2; v[4 * q + 3] = t3; s += (t0 * t0 + t1 * t1) + (t2 * t2 + t3 * t3);
        }
        const float rs = rsqrtf(wave_sum(s) * (1.f / DM) + EPS);
        f32x4* o = (f32x4*)(a.outp() + (size_t)m * DM) + 4 * lane;
#pragma unroll
        for (int q = 0; q < 4; ++q) { const f32x4 f = *(const f32x4*)(a.inp(I_FING) + 16 * lane + 4 * q);
            o[q] = (f32x4){v[4 * q] * rs * f.x, v[4 * q + 1] * rs * f.y, v[4 * q + 2] * rs * f.z, v[4 * q + 3] * rs * f.w}; }
#pragma unroll
        for (int j = 0; j < 2; ++j) cx[j] = nx[j];
#pragma unroll
        for (int j = 0; j < 4; ++j) cy[j] = ny[j];
    }
#undef P8_LOAD
}

__device__ __forceinline__ void glds16(const void* gsrc, unsigned lds_dst) { unsigned keep;
    asm volatile("s_mov_b32 %0, m0\n\ts_mov_b32 m0, %2\n\ts_nop 0\n\tglobal_load_lds_dwordx4 %1, off\n\ts_mov_b32 m0, %0" : "=&s"(keep) : "v"(gsrc), "s"(lds_dst) : "memory"); }
__device__ __forceinline__ unsigned lds_addr(const LAS void* p) { return (unsigned)__builtin_amdgcn_readfirstlane((int)(unsigned)(unsigned long long)p); }

namespace pg8 {
#define PG8_LAS __attribute__((address_space(3)))
typedef short bf16x8 __attribute__((ext_vector_type(8)));
typedef int v4i __attribute__((ext_vector_type(4)));
typedef int v8i __attribute__((ext_vector_type(8)));
constexpr int BM = 256, BK = 64, HALF = 128, HTB = HALF * BK * 2, STAGE_BYTES = 8 * HTB, NXCD = 8, WGM = 8;
__host__ __device__ __forceinline__ int lds_byte(int r, int c) { const int st = (r >> 4) * 2 + (c >> 5), rr = r & 15, cc = c & 31, ob = rr * 64 + cc * 2; return st * 1024 + (ob ^ (((ob >> 9) & 1) << 5)); }
__host__ __device__ __forceinline__ void stage_rc(int b, int& R, int& C) { const int st = b / 1024, sb = b % 1024, swz = sb ^ (((sb >> 9) & 1) << 5); R = (st >> 1) * 16 + swz / 64; C = (st & 1) * 32 + (swz % 64) / 2; }
__host__ __device__ __forceinline__ int perm32(int rho) { const int n = rho >> 4, i = rho & 15; return 8 * (i >> 2) + 4 * n + (i & 3); }
__device__ __forceinline__ unsigned cvt_pk_bf16(float lo, float hi) { unsigned r; asm volatile("v_cvt_pk_bf16_f32 %0, %1, %2" : "=v"(r) : "v"(lo), "v"(hi)); return r; }

struct Unit { int pm, pn, e, nrows, slot; };

template <class Epi, class Sched, bool ALIGN_EPI>
__device__ __forceinline__ void gemm_phase(PG8_LAS unsigned char* lds, const void* Abase, unsigned Abytes, const void* Bbase, unsigned Bbytes, const int RB  ,
                                           const Sched& S, const Epi& E, const int wid) {
    const int lane = lane_id(), tid = wid * 64 + lane, wr = wid >> 2, wc = wid & 3, fr = lane & 15, fq = lane >> 4;
    const int nt = RB / 128;
    int R0, C0; stage_rc(tid * 16, R0, C0);
    const unsigned cb2 = (unsigned)C0 * 2u;
    const unsigned voffB = (unsigned)((Epi::PERM ? ((R0 & ~31) + perm32(R0 & 31)) : R0) * RB) + cb2;
    const __amdgpu_buffer_rsrc_t rsA = __builtin_amdgcn_make_buffer_rsrc((void*)Abase, 0, Abytes, 0x00020000);
    const __amdgpu_buffer_rsrc_t rsB = __builtin_amdgcn_make_buffer_rsrc((void*)Bbase, 0, Bbytes, 0x00020000);
    const unsigned hstep = (unsigned)HALF * RB;
    const unsigned ldsw = (unsigned)wid * 1024u;
    const int aoff = lds_byte(wr * 64 + fr, fq * 8), boff = lds_byte(wc * 32 + fr, fq * 8);
#define PG8_SA(b, h) (((b) * 2 + (h)) * HTB)
#define PG8_SB(b, h) ((4 + (b) * 2 + (h)) * HTB)
#define PG8_STAGE_B(bufoff, soff) do { _Pragma("unroll") for (int _i = 0; _i < 2; ++_i) \
        __builtin_amdgcn_raw_ptr_buffer_load_lds(rsB, (PG8_LAS void*)(lds + (bufoff) + ldsw + _i * 8192), 16, voffB, (soff) + (unsigned)(_i * 64 * RB), 0, 0); } while (0)
#define PG8_STAGE_A(bufoff, un, h, soff) do { _Pragma("unroll") for (int _i = 0; _i < 2; ++_i) \
        __builtin_amdgcn_raw_ptr_buffer_load_lds(rsA, (PG8_LAS void*)(lds + (bufoff) + ldsw + _i * 8192), 16, S.arow_off((un), (h) * HALF + R0 + 64 * _i) + cb2, (soff), 0, 0); } while (0)
#define PG8_LDA(dst, b, h) do { _Pragma("unroll") for (int m = 0; m < 4; ++m) _Pragma("unroll") for (int k = 0; k < 2; ++k) dst[m][k] = *(const PG8_LAS bf16x8*)(lds + PG8_SA(b, h) + aoff + m * 2048 + k * 1024); } while (0)
#define PG8_LDB(dst, b, h) do { _Pragma("unroll") for (int n = 0; n < 2; ++n) _Pragma("unroll") for (int k = 0; k < 2; ++k) dst[n][k] = *(const PG8_LAS bf16x8*)(lds + PG8_SB(b, h) + boff + n * 2048 + k * 1024); } while (0)
#define PG8_MMA(ai, bj, At, Bt) do { __builtin_amdgcn_s_setprio(1); _Pragma("unroll") for (int m = 0; m < 4; ++m) _Pragma("unroll") for (int n = 0; n < 2; ++n) _Pragma("unroll") for (int k = 0; k < 2; ++k) \
        acc[ai][bj][m][n] = __builtin_amdgcn_mfma_f32_16x16x32_bf16(Bt[n][k], At[m][k], acc[ai][bj][m][n], 0, 0, 0); __builtin_amdgcn_s_setprio(0); } while (0)
#define PG8_LDA8(dst, b, h) do { _Pragma("unroll") for (int m = 0; m < 4; ++m) { const v4i lo_ = *(const PG8_LAS v4i*)(lds + PG8_SA(b, h) + aoff + m * 2048), hi_ = *(const PG8_LAS v4i*)(lds + PG8_SA(b, h) + aoff + m * 2048 + 1024); \
        dst[m] = __builtin_shufflevector(lo_, hi_, 0, 1, 2, 3, 4, 5, 6, 7); } } while (0)
#define PG8_LDB8(dst, b, h) do { _Pragma("unroll") for (int n = 0; n < 2; ++n) { const v4i lo_ = *(const PG8_LAS v4i*)(lds + PG8_SB(b, h) + boff + n * 2048), hi_ = *(const PG8_LAS v4i*)(lds + PG8_SB(b, h) + boff + n * 2048 + 1024); \
        dst[n] = __builtin_shufflevector(lo_, hi_, 0, 1, 2, 3, 4, 5, 6, 7); } } while (0)
#define PG8_MMA8(ai, bj, A8_, B8_) do { __builtin_amdgcn_s_setprio(1); _Pragma("unroll") for (int m = 0; m < 4; ++m) _Pragma("unroll") for (int n = 0; n < 2; ++n) \
        acc[ai][bj][m][n] = __builtin_amdgcn_mfma_scale_f32_16x16x128_f8f6f4(B8_[n], A8_[m], acc[ai][bj][m][n], 0, 0, 0, 0, 0, 0);     __builtin_amdgcn_s_setprio(0); } while (0)
#define PG8_XLDA(b, h) do { if constexpr (Epi::FP8) PG8_LDA8(A8, b, h); else PG8_LDA(At, b, h); } while (0)
#define PG8_XLDB0(b, h) do { if constexpr (Epi::FP8) PG8_LDB8(B08, b, h); else PG8_LDB(B0, b, h); } while (0)
#define PG8_XLDB1(b, h) do { if constexpr (Epi::FP8) PG8_LDB8(B18, b, h); else PG8_LDB(B1, b, h); } while (0)
#define PG8_XMM0(ai, bj) do { if constexpr (Epi::FP8) PG8_MMA8(ai, bj, A8, B08); else PG8_MMA(ai, bj, At, B0); } while (0)
#define PG8_XMM1(ai, bj) do { if constexpr (Epi::FP8) PG8_MMA8(ai, bj, A8, B18); else PG8_MMA(ai, bj, At, B1); } while (0)
#define PG8_WAIT_V(n) asm volatile("s_waitcnt vmcnt(" #n ")" ::: "memory")
#define PG8_WAIT_L(n) asm volatile("s_waitcnt lgkmcnt(" #n ")" ::: "memory")
#define PG8_BAR __builtin_amdgcn_s_barrier()
#define PG8_SCHED __builtin_amdgcn_sched_barrier(0)
    Unit cur, nxt; int ui = 0;
    if (!S.next(0, cur)) return;
    f32x4 acc[2][2][4][2];
#pragma unroll
    for (int a = 0; a < 2; ++a)
#pragma unroll
        for (int b = 0; b < 2; ++b)
#pragma unroll
            for (int m = 0; m < 4; ++m)
#pragma unroll
                for (int n = 0; n < 2; ++n) acc[a][b][m][n] = (f32x4){0.f, 0.f, 0.f, 0.f};
    bf16x8 At[4][2], B0[2][2], B1[2][2];
    v8i A8[4], B08[2], B18[2];
    unsigned cBo = S.boff(cur);
    PG8_STAGE_B(PG8_SB(0, 0), cBo); PG8_STAGE_B(PG8_SB(0, 1), cBo + hstep); PG8_STAGE_A(PG8_SA(0, 0), cur, 0, 0u); PG8_STAGE_A(PG8_SA(0, 1), cur, 1, 0u);
    if (wr == 1) PG8_BAR;
    PG8_WAIT_V(2); PG8_BAR;
    PG8_STAGE_B(PG8_SB(1, 0), cBo + 128u); PG8_STAGE_A(PG8_SA(1, 0), cur, 0, 128u); PG8_STAGE_B(PG8_SB(1, 1), cBo + hstep + 128u);
    PG8_WAIT_V(6); PG8_BAR;
    for (;;) {
        if constexpr (Epi::BIAS) E.prefetch(cur, ui, wid);
        const bool has_next = S.next(ui + 1, nxt);
        const unsigned nBo = has_next ? S.boff(nxt) : cBo;
        for (int th = 0; th < (Epi::HAS_MID ? 2 : 1); ++th) {
        if constexpr (Epi::HAS_MID) { if (th == 1) E.mid(acc, ui, wr, lane_id() & 15); }
        const int tbeg = Epi::HAS_MID ? th * (nt / 2) : 0, tend = Epi::HAS_MID ? (th + 1) * (nt / 2) : nt;
#pragma unroll 1
        for (int t = tbeg; t < tend; t += 2) {
            const bool last = (t == nt - 2);
            const unsigned k1 = (unsigned)(t + 1) * 128u;
            const unsigned k2 = last ? 0u : (unsigned)(t + 2) * 128u;
            const unsigned k3 = k2 + 128u;
            const unsigned b2 = (last ? nBo : cBo) + k2, b3 = b2 + 128u;
            Unit u2 = cur; if (last && has_next) u2 = nxt;
            PG8_XLDB0(0, 0); PG8_XLDB1(0, 1); PG8_SCHED; PG8_XLDA(0, 0); PG8_STAGE_A(PG8_SA(1, 1), cur, 1, k1);
            PG8_WAIT_V(8); PG8_WAIT_L(0); PG8_BAR; PG8_XMM0(0, 0); PG8_XMM1(0, 1); PG8_BAR; PG8_SCHED;
            PG8_XLDA(0, 1); PG8_STAGE_B(PG8_SB(0, 0), b2); PG8_STAGE_B(PG8_SB(0, 1), b2 + hstep); PG8_STAGE_A(PG8_SA(0, 0), u2, 0, k2);
            PG8_WAIT_V(8); PG8_WAIT_L(0); PG8_BAR; PG8_XMM0(1, 0); PG8_XMM1(1, 1); PG8_BAR; PG8_SCHED;
            PG8_XLDB0(1, 0); PG8_XLDB1(1, 1); PG8_SCHED; PG8_XLDA(1, 0); PG8_STAGE_A(PG8_SA(0, 1), u2, 1, k2);
            PG8_WAIT_V(8); PG8_WAIT_L(0); PG8_BAR; PG8_XMM0(0, 0); PG8_XMM1(0, 1); PG8_BAR; PG8_SCHED;
            PG8_XLDA(1, 1); PG8_STAGE_B(PG8_SB(1, 0), b3); PG8_STAGE_B(PG8_SB(1, 1), b3 + hstep); PG8_STAGE_A(PG8_SA(1, 0), u2, 0, k3);
            PG8_WAIT_V(8); PG8_WAIT_L(0); PG8_BAR; PG8_XMM0(1, 0); PG8_XMM1(1, 1); PG8_BAR; PG8_SCHED;
        }
        }
        if constexpr (ALIGN_EPI) { if (wr == 0) PG8_BAR; }
        { const int l2 = lane_id(); E(acc, cur, ui, wr, wc, l2 & 15, l2 >> 4); }
        if (!has_next) break;
#pragma unroll
        for (int a = 0; a < 2; ++a)
#pragma unroll
            for (int b = 0; b < 2; ++b)
#pragma unroll
                for (int m = 0; m < 4; ++m)
#pragma unroll
                    for (int n = 0; n < 2; ++n) acc[a][b][m][n] = (f32x4){0.f, 0.f, 0.f, 0.f};
        cur = nxt; cBo = nBo; ++ui;
        if constexpr (ALIGN_EPI) { if (wr == 1) PG8_BAR; }
    }
    PG8_WAIT_V(0);
    if constexpr (!ALIGN_EPI) { if (wr == 0) PG8_BAR; }
    PG8_BAR;
#undef PG8_SA
#undef PG8_SB
#undef PG8_STAGE_A
#undef PG8_STAGE_B
#undef PG8_LDA
#undef PG8_LDB
#undef PG8_MMA
#undef PG8_MMA8
#undef PG8_LDA8
#undef PG8_LDB8
#undef PG8_XLDA
#undef PG8_XLDB0
#undef PG8_XLDB1
#undef PG8_XMM0
#undef PG8_XMM1
#undef PG8_WAIT_V
#undef PG8_WAIT_L
#undef PG8_BAR
#undef PG8_SCHED
}

struct StaticOrder {
    int nM, nN, nwg, G, c; const char* Bt; int K;
    __device__ void init(int M, int N, int G_, int c_, const void* Bt_, int K_) { nM = M / BM; nN = N / BM; nwg = nM * nN; G = G_; c = c_; Bt = (const char*)Bt_; K = K_; }
    __device__ __forceinline__ bool next(int i, Unit& u) const {
        const long L = (long)i * G + c; if (L >= nwg) return false;
        int wgid = (int)L; { const int q = nwg / NXCD, r = nwg % NXCD, xcd = wgid % NXCD, off = wgid / NXCD; wgid = (xcd < r ? xcd * (q + 1) : r * (q + 1) + (xcd - r) * q) + off; }
        const int nig = WGM * nN, gid = wgid / nig, fm = gid * WGM, gsz = (nM - fm) < WGM ? (nM - fm) : WGM;
        u.pm = fm + ((wgid % nig) % gsz); u.pn = (wgid % nig) / gsz; u.e = 0; u.nrows = 256; u.slot = i; return true;
    }
    __device__ __forceinline__ unsigned boff(const Unit& u) const { return (unsigned)u.pn * (unsigned)(BM * K * 2); }
    __device__ __forceinline__ unsigned arow_off(const Unit& u, int r) const { return (unsigned)(u.pm * BM + r) * (unsigned)(K * 2); }
};

struct EpiProj {
    static constexpr bool PERM = true, HAS_MID = false, FP8 = false, BIAS = false;
    bf16* O;
    __device__ __forceinline__ void operator()(const f32x4 (&acc)[2][2][4][2], const Unit& u, int ui, int wr, int wc, int fr, int fq) const {
        const int row0 = u.pm * BM + wr * 64 + fr; const int colt = u.pn * BM; const int t = colt / 512;
        bf16* base = O + (size_t)t * PROJ_STRIDE; const float sc = (t == 0) ? C2 : 1.f;
        const int col0 = (colt - t * 512) + wc * 32 + 8 * fq;
#pragma unroll
        for (int ai = 0; ai < 2; ++ai)
#pragma unroll
            for (int m = 0; m < 4; ++m) { bf16* rowp = base + (size_t)(row0 + ai * HALF + m * 16) * 512 + col0;
#pragma unroll
                for (int bj = 0; bj < 2; ++bj) { const f32x4 v0 = acc[ai][bj][m][0] * sc, v1 = acc[ai][bj][m][1] * sc;
                    u32x4 w; w.x = cvt_pk_bf16(v0[0], v0[1]); w.y = cvt_pk_bf16(v0[2], v0[3]); w.z = cvt_pk_bf16(v1[0], v1[1]); w.w = cvt_pk_bf16(v1[2], v1[3]);
                    *(u32x4*)(rowp + bj * HALF) = w; } }
    }
};

constexpr int MAXTILES = 544;
struct MoeTables { PG8_LAS int* te; PG8_LAS int* toff; PG8_LAS int* tn; PG8_LAS int* ent; PG8_LAS float* pw; int ntiles; };
__device__ __forceinline__ MoeTables moe_tables(PG8_LAS unsigned char* tab, const unsigned* cnt, int tid) {
    PG8_LAS int* tc = (PG8_LAS int*)tab;
    MoeTables T; T.te = tc + 64; T.toff = T.te + MAXTILES; T.tn = T.toff + MAXTILES; T.ent = T.tn + MAXTILES; T.pw = (PG8_LAS float*)(T.ent + 9 * 256);
    if (tid < 32) tc[tid] = (int)cnt[tid];
    __syncthreads();
    for (int t = tid; t < MAXTILES; t += 512) {
        int e = 0, accu = 0;
        for (; e < 32; ++e) { const int nt_e = (tc[e] + 255) >> 8; if (t < accu + nt_e) break; accu += nt_e; }
        if (e < 32) { const int off = (t - accu) * 256; T.te[t] = e; T.toff[t] = off; const int rem = tc[e] - off; T.tn[t] = rem < 256 ? rem : 256; }
    }
    if (tid == 0) { int s = 0; for (int e = 0; e < 32; ++e) s += (tc[e] + 255) >> 8; tc[32] = s; }
    __syncthreads();
    T.ntiles = __builtin_amdgcn_readfirstlane(tc[32]);
    return T;
}
struct MoeOrder {
    const char* Bt; int ncol, shift; MoeTables T; int xcd, iin, gx; int seq;
    __device__ __forceinline__ bool next(int i, Unit& u) const {
        int t, pn;
        if (seq) {
            const int nblk = gx * NXCD, nfull = T.ntiles / nblk, rem = T.ntiles - nfull * nblk;
            if (i < nfull * ncol) { t = (i / ncol) * nblk + xcd * gx + iin; pn = i % ncol; }
            else { const int r = (i - nfull * ncol) * nblk + iin * NXCD + xcd; if (r >= rem * ncol) return false; t = nfull * nblk + r / ncol; pn = r % ncol; }
        } else {
            const int rpx = gx / ncol, rl = iin / ncol; if (rl >= rpx) return false;
            t = (i * NXCD + xcd) * rpx + rl; if (t >= T.ntiles) return false; pn = iin % ncol;
        }
        u.e = __builtin_amdgcn_readfirstlane(T.te[t]); u.pm = __builtin_amdgcn_readfirstlane(T.toff[t]); u.nrows = __builtin_amdgcn_readfirstlane(T.tn[t]); u.pn = pn; u.slot = i; return true;
    }
    __device__ __forceinline__ void load_entries(const int* list, const float* pasg, int tid) const {
        const int w = tid >> 6, l = tid & 63; Unit u[3]; bool ok[3]; int en[3][4]; float pv[3][4];
#pragma unroll
        for (int j = 0; j < 3; ++j) { ok[j] = next(w + 8 * j, u[j]);
#pragma unroll
            for (int q = 0; q < 4; ++q) { const int r = 64 * q + l; en[j][q] = ok[j] ? list[u[j].e * NTOK + u[j].pm + (r < u[j].nrows ? r : 0)] : 0; } }
#pragma unroll
        for (int j = 0; j < 3; ++j)
#pragma unroll
            for (int q = 0; q < 4; ++q) pv[j][q] = (pasg && ok[j]) ? pasg[en[j][q]] : 0.f;
#pragma unroll
        for (int j = 0; j < 3; ++j) if (ok[j]) {
#pragma unroll
            for (int q = 0; q < 4; ++q) { T.ent[(w + 8 * j) * 256 + 64 * q + l] = en[j][q]; if (pasg) T.pw[(w + 8 * j) * 256 + 64 * q + l] = pv[j][q]; } }
        __syncthreads();
    }
    __device__ __forceinline__ unsigned boff(const Unit& u) const { return (unsigned)(u.e * ncol + u.pn) * (unsigned)(BM * 1024); }
    __device__ __forceinline__ unsigned arow_off(const Unit& u, int r) const { return (unsigned)(T.ent[u.slot * 256 + r] >> shift) * 1024u; }
};
struct EpiGU {
    static constexpr bool PERM = true, HAS_MID = false, FP8 = true, BIAS = true;
    PG8_LAS const int* ent; const float* bg; const float* bu; unsigned char* act; PG8_LAS const float* bl;
    __device__ __forceinline__ void prefetch(const Unit& u, int ui, int wid) const {
        if (wid == 0) { const int l = lane_id(); glds16((l < 32 ? bg : bu) + u.e * DE + u.pn * 128 + (l & 31) * 4, lds_addr(bl + (ui & 1) * 256)); }
    }
    __device__ __forceinline__ void operator()(const f32x4 (&acc)[2][2][4][2], const Unit& u, int ui, int wr, int wc, int fr, int fq) const {
        const int cb = u.pn * 128 + wc * 32 + 8 * fq;
        PG8_LAS const float* bp = bl + (ui & 1) * 256 + wc * 32 + 8 * fq;
        const f32x4 g0 = *(PG8_LAS const f32x4*)bp, g1 = *(PG8_LAS const f32x4*)(bp + 4), u0 = *(PG8_LAS const f32x4*)(bp + 128), u1 = *(PG8_LAS const f32x4*)(bp + 132);
        PG8_LAS const int* lp = ent + u.slot * 256;
        int en8[2][4];
#pragma unroll
        for (int ai = 0; ai < 2; ++ai)
#pragma unroll
            for (int m = 0; m < 4; ++m) en8[ai][m] = lp[ai * HALF + wr * 64 + m * 16 + fr];
        asm volatile("" : "+v"(en8[0][0]), "+v"(en8[0][1]), "+v"(en8[0][2]), "+v"(en8[0][3]), "+v"(en8[1][0]), "+v"(en8[1][1]), "+v"(en8[1][2]), "+v"(en8[1][3]));
#pragma unroll
        for (int ai = 0; ai < 2; ++ai)
#pragma unroll
            for (int m = 0; m < 4; ++m) { const int r = ai * HALF + wr * 64 + m * 16 + fr; const int entry = en8[ai][m];
                f32x4 gv[2] = {acc[ai][0][m][0] + g0, acc[ai][0][m][1] + g1}, uv[2] = {acc[ai][1][m][0] + u0, acc[ai][1][m][1] + u1}; float o[8];
#pragma unroll
                for (int n = 0; n < 2; ++n)
#pragma unroll
                    for (int i = 0; i < 4; ++i) { const float g = fminf(gv[n][i], 7.f), uu = fminf(fmaxf(uv[n][i], -7.f), 7.f);
                        o[4 * n + i] = (uu + 1.f) * g * __builtin_amdgcn_rcpf(1.f + __builtin_amdgcn_exp2f(-1.702f * 1.4426950408889634f * g)); }
                typedef unsigned u32x2 __attribute__((ext_vector_type(2)));
                const u32x2 w = {pk4_fp8_raw(o[0], o[1], o[2], o[3]), pk4_fp8_raw(o[4], o[5], o[6], o[7])};
                if (r < u.nrows) *(u32x2*)(act + (size_t)entry * DE + cb) = w; }
    }
};
struct EpiDown {
    static constexpr bool PERM = true, HAS_MID = false, FP8 = true, BIAS = true;
    PG8_LAS const int* ent; const float* bd; PG8_LAS const float* pw; unsigned char* yb; PG8_LAS const float* bl;
    __device__ __forceinline__ void prefetch(const Unit& u, int ui, int wid) const {
        if (wid == 0) { const int l = lane_id(); glds16(bd + u.e * DM + u.pn * BM + l * 4, lds_addr(bl + (ui & 1) * 256)); }
    }
    __device__ __forceinline__ void operator()(const f32x4 (&acc)[2][2][4][2], const Unit& u, int ui, int wr, int wc, int fr, int fq) const {
        const int cb = u.pn * BM + wc * 32 + 8 * fq;
        f32x4 bv[2][2];
#pragma unroll
        for (int bj = 0; bj < 2; ++bj)
#pragma unroll
            for (int n = 0; n < 2; ++n) bv[bj][n] = *(PG8_LAS const f32x4*)(bl + (ui & 1) * 256 + bj * HALF + wc * 32 + 8 * fq + 4 * n);
        PG8_LAS const int* lp = ent + u.slot * 256;
        int en8[2][4]; float p8[2][4];
#pragma unroll
        for (int ai = 0; ai < 2; ++ai)
#pragma unroll
            for (int m = 0; m < 4; ++m) { en8[ai][m] = lp[ai * HALF + wr * 64 + m * 16 + fr]; p8[ai][m] = pw[u.slot * 256 + ai * HALF + wr * 64 + m * 16 + fr]; }
        asm volatile("" : "+v"(en8[0][0]), "+v"(en8[0][1]), "+v"(en8[0][2]), "+v"(en8[0][3]), "+v"(en8[1][0]), "+v"(en8[1][1]), "+v"(en8[1][2]), "+v"(en8[1][3]));
        asm volatile("" : "+v"(p8[0][0]), "+v"(p8[0][1]), "+v"(p8[0][2]), "+v"(p8[0][3]), "+v"(p8[1][0]), "+v"(p8[1][1]), "+v"(p8[1][2]), "+v"(p8[1][3]));
#pragma unroll
        for (int ai = 0; ai < 2; ++ai)
#pragma unroll
            for (int m = 0; m < 4; ++m) { const int r = ai * HALF + wr * 64 + m * 16 + fr; const int entry = en8[ai][m]; const float p = p8[ai][m];
                unsigned char* rowp = yb + (size_t)entry * DM + cb;
#pragma unroll
                for (int bj = 0; bj < 2; ++bj) { const f32x4 v0 = (acc[ai][bj][m][0] + bv[bj][0]) * p, v1 = (acc[ai][bj][m][1] + bv[bj][1]) * p;
                    typedef unsigned u32x2 __attribute__((ext_vector_type(2)));
                    if (r < u.nrows) *(u32x2*)(rowp + bj * HALF) = (u32x2){pk4_fp8_m3(v0[0], v0[1], v0[2], v0[3]), pk4_fp8_m3(v1[0], v1[1], v1[2], v1[3])}; } }
    }
};
struct EpiOut {
    static constexpr bool PERM = true, HAS_MID = true, FP8 = false, BIAS = false;
    const float* x; const float* mod; bf16* x1b; float* ssx; PG8_LAS const float* rst;
    __device__ __forceinline__ void mid(f32x4 (&acc)[2][2][4][2], int ui, int wr, int fr) const {
#pragma unroll
        for (int ai = 0; ai < 2; ++ai)
#pragma unroll
            for (int m = 0; m < 4; ++m) { const int r = ai * HALF + wr * 64 + m * 16 + fr; const float ra = rst[(ui * 256 + r) * 2], rl = rst[(ui * 256 + r) * 2 + 1]; const float ratio = ra / rl;
#pragma unroll
                for (int bj = 0; bj < 2; ++bj)
#pragma unroll
                    for (int n = 0; n < 2; ++n) acc[ai][bj][m][n] = acc[ai][bj][m][n] * ratio; }
    }
    __device__ __forceinline__ void operator()(const f32x4 (&acc)[2][2][4][2], const Unit& u, int ui, int wr, int wc, int fr, int fq) const {
        const int b = (u.pm * BM) / SEQ; const float* gm = mod + b * 6144 + 2048;
        const int cb = u.pn * BM + wc * 32 + 8 * fq;
        f32x4 gv[2][2];
#pragma unroll
        for (int bj = 0; bj < 2; ++bj)
#pragma unroll
            for (int n = 0; n < 2; ++n) gv[bj][n] = *(const f32x4*)(gm + cb + bj * HALF + 4 * n);
#pragma unroll
        for (int ai = 0; ai < 2; ++ai)
#pragma unroll
            for (int m = 0; m < 4; ++m) { const int r = ai * HALF + wr * 64 + m * 16 + fr; const size_t grow = (size_t)u.pm * BM + r; const float rl = rst[(ui * 256 + r) * 2 + 1];
                float ss = 0.f;
#pragma unroll
                for (int bj = 0; bj < 2; ++bj) { const float* xp = x + grow * DM + cb + bj * HALF;
                    const f32x4 v0 = *(const f32x4*)xp + gv[bj][0] * (acc[ai][bj][m][0] * rl), v1 = *(const f32x4*)(xp + 4) + gv[bj][1] * (acc[ai][bj][m][1] * rl);
                    ss += (v0[0] * v0[0] + v0[1] * v0[1]) + (v0[2] * v0[2] + v0[3] * v0[3]) + (v1[0] * v1[0] + v1[1] * v1[1]) + (v1[2] * v1[2] + v1[3] * v1[3]);
                    u32x4 w; w.x = cvt_pk_bf16(v0[0], v0[1]); w.y = cvt_pk_bf16(v0[2], v0[3]); w.z = cvt_pk_bf16(v1[0], v1[1]); w.w = cvt_pk_bf16(v1[2], v1[3]);
                    *(u32x4*)(x1b + grow * DM + cb + bj * HALF) = w; }
                ss += __shfl_xor(ss, 16); ss += __shfl_xor(ss, 32);
                if (fq == 0) ssx[grow * 16 + u.pn * 4 + wc] = ss;
                asm volatile("" ::: "memory"); }
    }
};
}


__device__ __forceinline__ void p5_router(const Args& a, LAS unsigned char* lds, int tid, int lane, int wave, int G) {
    typedef short bf16x8 __attribute__((ext_vector_type(8)));
    LAS float* ab = (LAS float*)(lds + TAB_OFF);
    LAS float* lg = ab + 2048 + wave * 512;
    LAS unsigned* hist = (LAS unsigned*)(lds + TAB_OFF + 8192 + 16384);
    const int col = lane & 15, kq = lane >> 4;
    const bf16* x1b = (const bf16*)(a.wsp() + WS_X1B);
    u32x4 xv[32];
#define P5_LOADX(bt) do { const u32x4* xr_ = (const u32x4*)(x1b + (size_t)((bt) * 128 + wave * 16 + col) * DM) + kq; _Pragma("unroll") for (int i_ = 0; i_ < 32; ++i_) xv[i_] = xr_[4 * i_]; } while (0)
    if ((int)blockIdx.x < NTOK / 128) P5_LOADX((int)blockIdx.x);
    { const u32x4* wsrc = (const u32x4*)(a.wsp() + WS_WR);
      for (int i = tid; i < 2 * 32 * 128; i += 512) { const int hl = i >> 12, e = (i >> 7) & 31, c = i & 127;
          *(LAS u32x4*)(lds + hl * 65536 + e * 2048 + ((c ^ (e & 15)) << 4)) = wsrc[i]; } }
    const float* mod = (const float*)(a.wsp() + WS_MOD); const float* ssx = (const float*)(a.wsp() + WS_SSX);
    unsigned char* h2 = (unsigned char*)a.outp() + DO_H2;
    unsigned* cnt = (unsigned*)(a.wsp() + WS_CTL) + CW_CNT; int* list = (int*)(a.wsp() + WS_LIST); float* pasg = (float*)(a.wsp() + WS_PASG);
    int cur_b = -1;
    for (int batch = blockIdx.x; batch < NTOK / 128; batch += G) {
        const int b = (batch * 128) / SEQ;
        __syncthreads();
        if (b != cur_b) { for (int k = tid; k < 1024; k += 512) { ab[k] = a.inp(I_FFNG)[k] * (1.f + mod[b * 6144 + 4096 + k]); ab[1024 + k] = mod[b * 6144 + 3072 + k]; } cur_b = b; }
        if (tid < 64) hist[tid] = 0u;
        __syncthreads();
        const int tok = batch * 128 + wave * 16 + col;
        float rs2;
        { const f32x4 pp = *(const f32x4*)(ssx + (size_t)tok * 16 + 4 * kq); float s = (pp.x + pp.y) + (pp.z + pp.w); s += __shfl_xor(s, 16); s += __shfl_xor(s, 32); rs2 = rsqrtf(s * (1.f / 1024.f) + EPS); }
        typedef unsigned u32x2 __attribute__((ext_vector_type(2))); u32x2* hrow = (u32x2*)(h2 + (size_t)tok * DM) + kq;
        f32x4 acc0 = {0.f, 0.f, 0.f, 0.f}, acc1 = {0.f, 0.f, 0.f, 0.f};
        const LAS unsigned char* wb = lds + col * 2048;
#pragma unroll
        for (int kb = 0; kb < 32; kb += 8) {
#pragma unroll
            for (int i = 0; i < 8; ++i) { const int ks = kb + i;
                float xf[8]; unpack8(xv[ks], xf);
                const LAS f32x4* al = (const LAS f32x4*)(ab + 32 * ks + 8 * kq); const LAS f32x4* be = (const LAS f32x4*)(ab + 1024 + 32 * ks + 8 * kq);
                const f32x4 a0 = al[0], a1 = al[1], b0 = be[0], b1 = be[1];
                float h[8] = {xf[0] * rs2 * a0.x + b0.x, xf[1] * rs2 * a0.y + b0.y, xf[2] * rs2 * a0.z + b0.z, xf[3] * rs2 * a0.w + b0.w,
                              xf[4] * rs2 * a1.x + b1.x, xf[5] * rs2 * a1.y + b1.y, xf[6] * rs2 * a1.z + b1.z, xf[7] * rs2 * a1.w + b1.w};
                u32x4 hh, hl;
                hh.x = pg8::cvt_pk_bf16(h[0], h[1]); hh.y = pg8::cvt_pk_bf16(h[2], h[3]); hh.z = pg8::cvt_pk_bf16(h[4], h[5]); hh.w = pg8::cvt_pk_bf16(h[6], h[7]);
                float hf[8]; unpack8(hh, hf);
                hl.x = pg8::cvt_pk_bf16(h[0] - hf[0], h[1] - hf[1]); hl.y = pg8::cvt_pk_bf16(h[2] - hf[2], h[3] - hf[3]); hl.z = pg8::cvt_pk_bf16(h[4] - hf[4], h[5] - hf[5]); hl.w = pg8::cvt_pk_bf16(h[6] - hf[6], h[7] - hf[7]);
                hrow[4 * ks] = (u32x2){pk4_fp8_m3(h[0], h[1], h[2], h[3]), pk4_fp8_m3(h[4], h[5], h[6], h[7])};
                const int so = ((4 * ks + kq) ^ col) << 4;
                const bf16x8 bh0 = *(const LAS bf16x8*)(wb + so), bh1 = *(const LAS bf16x8*)(wb + 32768 + so), bl0 = *(const LAS bf16x8*)(wb + 65536 + so), bl1 = *(const LAS bf16x8*)(wb + 65536 + 32768 + so);
                const bf16x8 ah = __builtin_bit_cast(bf16x8, hh), alo = __builtin_bit_cast(bf16x8, hl);
                acc0 = __builtin_amdgcn_mfma_f32_16x16x32_bf16(ah, bh0, acc0, 0, 0, 0); acc1 = __builtin_amdgcn_mfma_f32_16x16x32_bf16(ah, bh1, acc1, 0, 0, 0);
                acc0 = __builtin_amdgcn_mfma_f32_16x16x32_bf16(ah, bl0, acc0, 0, 0, 0); acc1 = __builtin_amdgcn_mfma_f32_16x16x32_bf16(ah, bl1, acc1, 0, 0, 0);
                acc0 = __builtin_amdgcn_mfma_f32_16x16x32_bf16(alo, bh0, acc0, 0, 0, 0); acc1 = __builtin_amdgcn_mfma_f32_16x16x32_bf16(alo, bh1, acc1, 0, 0, 0);
            }
        }
        if (batch + G < NTOK / 128) P5_LOADX(batch + G);
        { const float rb0 = a.inp(I_RB)[col], rb1 = a.inp(I_RB)[16 + col];
#pragma unroll
          for (int r = 0; r < 4; ++r) { lg[(4 * kq + r) * 32 + col] = acc0[r] + rb0; lg[(4 * kq + r) * 32 + 16 + col] = acc1[r] + rb1; } }
        LDS_WAIT();
        int e0 = 0, e1 = 0, e2 = 0, e3 = 0; unsigned r0 = 0, r1 = 0, r2 = 0, r3 = 0; float p0 = 0.f, p1 = 0.f, p2 = 0.f, p3 = 0.f;
        if (lane < 16) {
            float v[32];
#pragma unroll
            for (int q = 0; q < 8; ++q) { const f32x4 t = *(const LAS f32x4*)(lg + lane * 32 + 4 * q); v[4 * q] = t.x; v[4 * q + 1] = t.y; v[4 * q + 2] = t.z; v[4 * q + 3] = t.w; }
            unsigned chosen = 0u; float tv[4]; int ti[4];
#pragma unroll
            for (int k = 0; k < 4; ++k) { float bv = -INFINITY; int bi = 0;
#pragma unroll
                for (int e = 0; e < 32; ++e) { const float c = ((chosen >> e) & 1u) ? -INFINITY : v[e]; if (c > bv) { bv = c; bi = e; } }
                tv[k] = bv; ti[k] = bi; chosen |= 1u << bi; }
            const float q1 = __expf(tv[1] - tv[0]), q2 = __expf(tv[2] - tv[0]), q3 = __expf(tv[3] - tv[0]), inv = 1.f / (1.f + q1 + q2 + q3);
            e0 = ti[0]; e1 = ti[1]; e2 = ti[2]; e3 = ti[3]; p0 = inv; p1 = q1 * inv; p2 = q2 * inv; p3 = q3 * inv;
            r0 = __hip_atomic_fetch_add(hist + e0, 1u, __ATOMIC_RELAXED, __HIP_MEMORY_SCOPE_WORKGROUP); r1 = __hip_atomic_fetch_add(hist + e1, 1u, __ATOMIC_RELAXED, __HIP_MEMORY_SCOPE_WORKGROUP);
            r2 = __hip_atomic_fetch_add(hist + e2, 1u, __ATOMIC_RELAXED, __HIP_MEMORY_SCOPE_WORKGROUP); r3 = __hip_atomic_fetch_add(hist + e3, 1u, __ATOMIC_RELAXED, __HIP_MEMORY_SCOPE_WORKGROUP);
        }
        __syncthreads();
        if (tid < 32) hist[32 + tid] = atomicAdd(&cnt[tid], hist[tid]);
        __syncthreads();
        if (lane < 16) { const int tk = batch * 128 + wave * 16 + lane;
            list[e0 * NTOK + hist[32 + e0] + r0] = tk * 4 + 0; list[e1 * NTOK + hist[32 + e1] + r1] = tk * 4 + 1; list[e2 * NTOK + hist[32 + e2] + r2] = tk * 4 + 2; list[e3 * NTOK + hist[32 + e3] + r3] = tk * 4 + 3;
            *(f32x4*)(pasg + (size_t)tk * 4) = (f32x4){p0, p1, p2, p3}; }
    }
}


namespace att {
typedef short bf16x8 __attribute__((ext_vector_type(8)));
typedef short s16x4 __attribute__((ext_vector_type(4)));
typedef float f32x16 __attribute__((ext_vector_type(16)));
constexpr int NTW = 6;
constexpr int LDS_K = 0, LDS_V = NTW * 8192, LDS_FLAG = 2 * NTW * 8192;
constexpr float ATT_THR = 32.f;
__device__ __forceinline__ int crow(int r, int hh) { return (r & 3) + 8 * (r >> 2) + 4 * hh; }
__device__ __forceinline__ bf16x8 pack8(const float* v) {
    u32x4 w; w.x = pg8::cvt_pk_bf16(v[0], v[1]); w.y = pg8::cvt_pk_bf16(v[2], v[3]); w.z = pg8::cvt_pk_bf16(v[4], v[5]); w.w = pg8::cvt_pk_bf16(v[6], v[7]); return __builtin_bit_cast(bf16x8, w);
}
__device__ __forceinline__ s16x4 vtr(const LAS unsigned char* p) { typedef short v4i16_t __attribute__((ext_vector_type(4))); return __builtin_bit_cast(s16x4, __builtin_amdgcn_ds_read_tr16_b64_v4i16((LAS v4i16_t*)p)); }
template <bool DIAG>
__device__ __forceinline__ void block32(f32x16& o0, f32x16& o1, float& c, const bf16x8 (&qf)[4], const bf16x8 (&Mf)[2], const LAS unsigned char* Kb, const LAS unsigned char* Vb, int kbl, int r32, int hh, int lane) {
    f32x16 st = {0.f, 0.f, 0.f, 0.f, 0.f, 0.f, 0.f, 0.f, 0.f, 0.f, 0.f, 0.f, 0.f, 0.f, 0.f, 0.f};
#pragma unroll
    for (int ks = 0; ks < 4; ++ks) { const bf16x8 kf = *(const LAS bf16x8*)(Kb + (2 * ks + hh) * 1024 + (32 * kbl + r32) * 16); st = __builtin_amdgcn_mfma_f32_32x32x16_bf16(kf, qf[ks], st, 0, 0, 0); }
    float u[16], L[16];
#pragma unroll
    for (int r = 0; r < 16; ++r) { float uu = __builtin_amdgcn_exp2f(fminf(st[r], 115.f)); if (DIAG) { if (crow(r, hh) >= r32) uu = 0.f; } u[r] = uu; L[r] = __builtin_amdgcn_logf(1.f + uu); }
    const bf16x8 lp0 = pack8(L), lp1 = pack8(L + 8);
    f32x16 inc = {0.f, 0.f, 0.f, 0.f, 0.f, 0.f, 0.f, 0.f, 0.f, 0.f, 0.f, 0.f, 0.f, 0.f, 0.f, 0.f};
    inc = __builtin_amdgcn_mfma_f32_32x32x16_bf16(Mf[0], lp0, inc, 0, 0, 0); inc = __builtin_amdgcn_mfma_f32_32x32x16_bf16(Mf[1], lp1, inc, 0, 0, 0);
    float tot; { const unsigned t0 = __float_as_uint(inc[0]); auto rr = __builtin_amdgcn_permlane32_swap(t0, t0, false, false); tot = __uint_as_float(rr[0]); }
    float w[16];
#pragma unroll
    for (int r = 0; r < 16; ++r) w[r] = u[r] * __builtin_amdgcn_exp2f(inc[r] + c);
    c += tot;
    const bf16x8 pw0 = pack8(w), pw1 = pack8(w + 8);
    const LAS unsigned char* vp = Vb + ((lane >> 4) & 1) * 32 + (lane & 3) * 8 + (4 * hh + ((lane & 15) >> 2)) * 64 + (2 * kbl) * 1024;
#pragma unroll
    for (int db = 0; db < 2; ++db) {
        const s16x4 l0 = vtr(vp + db * 4096), h0 = vtr(vp + db * 4096 + 512), l1 = vtr(vp + db * 4096 + 1024), h1 = vtr(vp + db * 4096 + 1024 + 512);
        const bf16x8 v0 = (bf16x8){l0[0], l0[1], l0[2], l0[3], h0[0], h0[1], h0[2], h0[3]}, v1 = (bf16x8){l1[0], l1[1], l1[2], l1[3], h1[0], h1[1], h1[2], h1[3]};
        if (db == 0) { o0 = __builtin_amdgcn_mfma_f32_32x32x16_bf16(v0, pw0, o0, 0, 0, 0); o0 = __builtin_amdgcn_mfma_f32_32x32x16_bf16(v1, pw1, o0, 0, 0, 0); }
        else         { o1 = __builtin_amdgcn_mfma_f32_32x32x16_bf16(v0, pw0, o1, 0, 0, 0); o1 = __builtin_amdgcn_mfma_f32_32x32x16_bf16(v1, pw1, o1, 0, 0, 0); }
    }
}
__device__ __forceinline__ void tile64(f32x16& o0, f32x16& o1, float& c, const bf16x8 (&qf)[4], const bf16x8 (&Mf)[2], const LAS unsigned char* Kb, const LAS unsigned char* Vb, int r32, int hh, int lane) {
    const f32x16 z16 = {0.f, 0.f, 0.f, 0.f, 0.f, 0.f, 0.f, 0.f, 0.f, 0.f, 0.f, 0.f, 0.f, 0.f, 0.f, 0.f};
    bf16x8 kf[8];
#pragma unroll
    for (int q = 0; q < 8; ++q) kf[q] = *(const LAS bf16x8*)(Kb + (2 * (q & 3) + hh) * 1024 + (32 * (q >> 2) + r32) * 16);
    asm volatile("" : "+v"(kf[0]), "+v"(kf[1]), "+v"(kf[2]), "+v"(kf[3]), "+v"(kf[4]), "+v"(kf[5]), "+v"(kf[6]), "+v"(kf[7]));
    f32x16 sl = z16, su = z16;
#pragma unroll
    for (int ks = 0; ks < 4; ++ks) { su = __builtin_amdgcn_mfma_f32_32x32x16_bf16(kf[4 + ks], qf[ks], su, 0, 0, 0); sl = __builtin_amdgcn_mfma_f32_32x32x16_bf16(kf[ks], qf[ks], sl, 0, 0, 0); }
    float uu[16], ul[16], L[16];
#pragma unroll
    for (int r = 0; r < 16; ++r) { uu[r] = __builtin_amdgcn_exp2f(fminf(su[r], 115.f)); L[r] = __builtin_amdgcn_logf(1.f + uu[r]); }
    const bf16x8 lu0 = pack8(L), lu1 = pack8(L + 8);
    f32x16 iu = __builtin_amdgcn_mfma_f32_32x32x16_bf16(Mf[0], lu0, z16, 0, 0, 0); iu = __builtin_amdgcn_mfma_f32_32x32x16_bf16(Mf[1], lu1, iu, 0, 0, 0);
#pragma unroll
    for (int r = 0; r < 16; ++r) { ul[r] = __builtin_amdgcn_exp2f(fminf(sl[r], 115.f)); L[r] = __builtin_amdgcn_logf(1.f + ul[r]); }
    const bf16x8 ll0 = pack8(L), ll1 = pack8(L + 8);
    f32x16 il = __builtin_amdgcn_mfma_f32_32x32x16_bf16(Mf[0], ll0, z16, 0, 0, 0); il = __builtin_amdgcn_mfma_f32_32x32x16_bf16(Mf[1], ll1, il, 0, 0, 0);
    const LAS unsigned char* vp = Vb + ((lane >> 4) & 1) * 32 + (lane & 3) * 8 + (4 * hh + ((lane & 15) >> 2)) * 64;
    s16x4 vl[2][4], vh[2][4];
#pragma unroll
    for (int db = 0; db < 2; ++db)
#pragma unroll
        for (int g = 0; g < 4; ++g) { vl[db][g] = vtr(vp + db * 4096 + g * 1024); vh[db][g] = vtr(vp + db * 4096 + g * 1024 + 512); }
    float totu, totl;
    { const unsigned t0 = __float_as_uint(iu[0]); auto rr = __builtin_amdgcn_permlane32_swap(t0, t0, false, false); totu = __uint_as_float(rr[0]); }
    { const unsigned t0 = __float_as_uint(il[0]); auto rr = __builtin_amdgcn_permlane32_swap(t0, t0, false, false); totl = __uint_as_float(rr[0]); }
    float w[16];
#pragma unroll
    for (int r = 0; r < 16; ++r) w[r] = uu[r] * __builtin_amdgcn_exp2f(iu[r] + c);
    const bf16x8 pu0 = pack8(w), pu1 = pack8(w + 8);
    const float c1 = c + totu;
#pragma unroll
    for (int r = 0; r < 16; ++r) w[r] = ul[r] * __builtin_amdgcn_exp2f(il[r] + c1);
    const bf16x8 pl0 = pack8(w), pl1 = pack8(w + 8);
    c = c1 + totl;
#define ATT_VF(db, g) (bf16x8){vl[db][g][0], vl[db][g][1], vl[db][g][2], vl[db][g][3], vh[db][g][0], vh[db][g][1], vh[db][g][2], vh[db][g][3]}
    o0 = __builtin_amdgcn_mfma_f32_32x32x16_bf16(ATT_VF(0, 2), pu0, o0, 0, 0, 0); o1 = __builtin_amdgcn_mfma_f32_32x32x16_bf16(ATT_VF(1, 2), pu0, o1, 0, 0, 0);
    o0 = __builtin_amdgcn_mfma_f32_32x32x16_bf16(ATT_VF(0, 3), pu1, o0, 0, 0, 0); o1 = __builtin_amdgcn_mfma_f32_32x32x16_bf16(ATT_VF(1, 3), pu1, o1, 0, 0, 0);
    o0 = __builtin_amdgcn_mfma_f32_32x32x16_bf16(ATT_VF(0, 0), pl0, o0, 0, 0, 0); o1 = __builtin_amdgcn_mfma_f32_32x32x16_bf16(ATT_VF(1, 0), pl0, o1, 0, 0, 0);
    o0 = __builtin_amdgcn_mfma_f32_32x32x16_bf16(ATT_VF(0, 1), pl1, o0, 0, 0, 0); o1 = __builtin_amdgcn_mfma_f32_32x32x16_bf16(ATT_VF(1, 1), pl1, o1, 0, 0, 0);
#undef ATT_VF
}
__device__ __forceinline__ void attn_unit(const bf16* Q, const bf16* K, const bf16* V, bf16* Y, float* ssa, LAS unsigned char* lds, int b, int h, int qt, int wave, int lane) {
    const int r32 = lane & 31, hh = lane >> 5;
    const size_t rowbase = (size_t)b * SEQ; const int tq0 = 256 * qt + 32 * wave;
    const bf16* Kh = K + rowbase * 512 + h * 64; const bf16* Vh = V + rowbase * 512 + h * 64;
    const bf16* ksrc = Kh + (size_t)lane * 512 + wave * 8;
    const bf16* vsrc = Vh + (size_t)(16 * (wave & 3) + (lane >> 2)) * 512 + (wave >> 2) * 32 + (lane & 3) * 8;
#define ATT_STAGE(kt, buf) do { glds16(ksrc + (size_t)(kt) * 64 * 512, lds_addr(lds + LDS_K + (buf) * 8192 + wave * 1024)); \
                                glds16(vsrc + (size_t)(kt) * 64 * 512, lds_addr(lds + LDS_V + (buf) * 8192 + wave * 1024)); } while (0)
    const int kt_hi = 4 * qt + 3;
    const int nw = (kt_hi + 1 < NTW) ? kt_hi + 1 : NTW;
#pragma unroll
    for (int j = 0; j < NTW; ++j) if (j < nw) ATT_STAGE(kt_hi - j, j);
    bf16x8 qf[4];
    { const bf16* qp = Q + (rowbase + tq0 + r32) * 512 + h * 64 + 8 * hh;
#pragma unroll
      for (int ks = 0; ks < 4; ++ks) qf[ks] = *(const bf16x8*)(qp + 16 * ks); }
    bf16x8 Mf[2];
#pragma unroll
    for (int ks = 0; ks < 2; ++ks)
#pragma unroll
        for (int j = 0; j < 8; ++j) Mf[ks][j] = ((16 * ks + 8 * (j >> 2) + 4 * hh + (j & 3)) >= r32) ? (short)0xBF80 : (short)0;
    f32x16 o0 = {0.f, 0.f, 0.f, 0.f, 0.f, 0.f, 0.f, 0.f, 0.f, 0.f, 0.f, 0.f, 0.f, 0.f, 0.f, 0.f}, o1 = o0;
    float c = 0.f; bool done = false;
    LAS unsigned* flags = (LAS unsigned*)(lds + LDS_FLAG);
    asm volatile("" :: "v"(qf[0]), "v"(qf[1]), "v"(qf[2]), "v"(qf[3]));
    asm volatile("s_waitcnt vmcnt(0)\n\ts_barrier" ::: "memory");
#define ATT_TILE(kt, buf) do { const LAS unsigned char* Kb = lds + LDS_K + (buf) * 8192; const LAS unsigned char* Vb = lds + LDS_V + (buf) * 8192; \
            if (64 * (kt) + 32 < tq0) tile64(o0, o1, c, qf, Mf, Kb, Vb, r32, hh, lane);        \
            else { _Pragma("unroll") for (int kbl = 1; kbl >= 0; --kbl) { const int s0 = 64 * (kt) + 32 * kbl; \
                    if (s0 < tq0) block32<false>(o0, o1, c, qf, Mf, Kb, Vb, kbl, r32, hh, lane); \
                    else if (s0 == tq0) block32<true>(o0, o1, c, qf, Mf, Kb, Vb, kbl, r32, hh, lane); } } \
            done = __all(c < -ATT_THR) != 0; } while (0)
#pragma unroll 1
    for (int j = 0; j < nw; ++j) { if (done) break; const int kt = kt_hi - j; if (64 * kt >= tq0 + 32) continue;     ATT_TILE(kt, j); }
    if (lane == 0) flags[24 + wave] = done ? 1u : 0u;
    asm volatile("s_waitcnt lgkmcnt(0)\n\ts_barrier" ::: "memory");
    bool all_done;
    { const u32x4 f0 = *(const LAS u32x4*)(flags + 24), f1 = *(const LAS u32x4*)(flags + 28); all_done = (f0.x & f0.y & f0.z & f0.w & f1.x & f1.y & f1.z & f1.w) != 0u; }
    const int kt_s = kt_hi - nw;
    if (!all_done && kt_s >= 0) {
        ATT_STAGE(kt_s, 0); if (kt_s >= 1) ATT_STAGE(kt_s - 1, 1);
        int buf = 0, bprev = 2;
        for (int kt = kt_s; kt >= 0; --kt) {
            if (kt >= 1) asm volatile("s_waitcnt vmcnt(2) lgkmcnt(0)\n\ts_barrier" ::: "memory");
            else asm volatile("s_waitcnt vmcnt(0) lgkmcnt(0)\n\ts_barrier" ::: "memory");
            if (kt != kt_s) { const u32x4 f0 = *(const LAS u32x4*)(flags + bprev * 8), f1 = *(const LAS u32x4*)(flags + bprev * 8 + 4);
                if ((f0.x & f0.y & f0.z & f0.w & f1.x & f1.y & f1.z & f1.w) != 0u) break; }
            if (kt >= 2) ATT_STAGE(kt - 2, bprev);
            if (!done) ATT_TILE(kt, buf);
            if (lane == 0) flags[buf * 8 + wave] = done ? 1u : 0u;
            bprev = buf; buf = (buf == 2) ? 0 : buf + 1;
        }
        asm volatile("s_waitcnt vmcnt(0) lgkmcnt(0)\n\ts_barrier" ::: "memory");
    }
#undef ATT_TILE
    asm volatile("s_waitcnt vmcnt(0)" ::: "memory");
    float ss = 0.f;
    bf16* yp = Y + (rowbase + tq0 + r32) * DM + h * 64 + 4 * hh;
#pragma unroll
    for (int g = 0; g < 4; ++g) {
        const float a0 = o0[4 * g], a1 = o0[4 * g + 1], a2 = o0[4 * g + 2], a3 = o0[4 * g + 3], b0 = o1[4 * g], b1 = o1[4 * g + 1], b2 = o1[4 * g + 2], b3 = o1[4 * g + 3];
        ss += (a0 * a0 + a1 * a1) + (a2 * a2 + a3 * a3) + (b0 * b0 + b1 * b1) + (b2 * b2 + b3 * b3);
        *(unsigned long long*)(yp + 8 * g) = (unsigned long long)pg8::cvt_pk_bf16(a0, a1) | ((unsigned long long)pg8::cvt_pk_bf16(a2, a3) << 32);
        *(unsigned long long*)(yp + 32 + 8 * g) = (unsigned long long)pg8::cvt_pk_bf16(b0, b1) | ((unsigned long long)pg8::cvt_pk_bf16(b2, b3) << 32);
    }
    { const unsigned t0 = __float_as_uint(ss); auto rr = __builtin_amdgcn_permlane32_swap(t0, t0, false, false); ss = __uint_as_float(rr[0]) + __uint_as_float(rr[1]); }
    if (hh == 0) ssa[(rowbase + tq0 + r32) * 8 + h] = ss;
#undef ATT_STAGE
}
__device__ __forceinline__ void attn_phase(const Args& a, LAS unsigned char* lds, int wave, int lane, int G, int bx) {
    const bf16* Q = (const bf16*)(a.wsp() + WS_PROJ); const bf16* K = Q + PROJ_STRIDE; const bf16* V = K + PROJ_STRIDE;
    bf16* Y = (bf16*)((unsigned char*)a.outp() + DO_Y); float* ssa = (float*)(a.wsp() + WS_SSA);
    for (int u = bx; u < BATCH * NH * 16; u += G) {
        const int bh = u % 64, qt = (u / 64 + bh) % 16;
        attn_unit(Q, K, V, Y, ssa, lds, bh / NH, bh % NH, qt, wave, lane);
    }
}
}


namespace lru {
typedef short bf16x8 __attribute__((ext_vector_type(8)));
template <int CTRL> __device__ __forceinline__ float dpp_f(float v) { return __builtin_bit_cast(float, __builtin_amdgcn_update_dpp(0, __builtin_bit_cast(int, v), CTRL, 0xF, 0xF, true)); }
constexpr int WP = 64, NSTEP = SEQ / (8 * WP), XBUF = 8576  , WT = 2 * 8 * XBUF  , GRB = WT + 2048  ;
__device__ __forceinline__ void lru_item(const Args& a, LAS unsigned char* lds, int b, int cg, int wave, int lane) {
    const int g = cg >> 2, j0 = 16 * (cg & 3), ch0 = 16 * cg;
    const bf16* XR = (const bf16*)(a.wsp() + WS_PROJ) + 3 * PROJ_STRIDE + (size_t)b * SEQ * 512 + g * 64;
    const bf16* GR = (const bf16*)(a.wsp() + WS_PROJ) + 4 * PROJ_STRIDE + (size_t)b * SEQ * 512 + ch0;
    bf16* Y = (bf16*)((unsigned char*)a.outp() + DO_Y) + (size_t)b * SEQ * DM + 512 + ch0;
    float* ssl = (float*)(a.wsp() + WS_SSL) + (size_t)cg * NTOK + (size_t)b * SEQ;
    __syncthreads();
    LAS unsigned char* xb = lds + wave * (2 * XBUF);
    LAS unsigned char* gb = lds + GRB + wave * 2048;
#define LRU_DMA(p0, buf) do { const bf16* s_ = XR + ((long)(p0) - 3 + (lane >> 3)) * 512 + 8 * (lane & 7); \
        _Pragma("unroll") for (int j_ = 0; j_ < 8; ++j_) glds16(s_ + (long)j_ * 8 * 512, lds_addr(xb + (buf) * XBUF + j_ * 1024)); \
        if (lane < 24) glds16(s_ + (long)8 * 8 * 512, lds_addr(xb + (buf) * XBUF + 8 * 1024)); } while (0)
#define LRU_DMA_GR(p0) do { const bf16* g_ = GR + (size_t)((p0) + (lane >> 1)) * 512 + 8 * (lane & 1); \
        glds16(g_, lds_addr(gb)); glds16(g_ + 32 * 512, lds_addr(gb + 1024)); } while (0)
    LRU_DMA(64 * wave, 0); LRU_DMA_GR(64 * wave);
    const int c = lane & 15, pq = lane >> 4;
    bf16x8 wrf[4][2], wif[4][2];
    const int ch = ch0 + c;
    float rgb = a.inp(I_RGB)[ch], igb = a.inp(I_IGB)[ch];
    { const float* rw = a.inp(I_RGW) + (size_t)g * 4096 + j0 + c; const float* iw = a.inp(I_IGW) + (size_t)g * 4096 + j0 + c;
      const float* cwp = a.inp(I_CONVW) + g * 64; const float* cbp = a.inp(I_CONVB) + g * 64;
#pragma unroll
      for (int ks = 0; ks < 2; ++ks) { float wr_[8], wi_[8];
#pragma unroll
          for (int jj = 0; jj < 8; ++jj) { const int k = 32 * ks + 8 * pq + jj; wr_[jj] = rw[k * 64]; wi_[jj] = iw[k * 64]; }
#pragma unroll
          for (int j = 0; j < 4; ++j) { float tr[8], ti[8];
#pragma unroll
              for (int jj = 0; jj < 8; ++jj) { const float cwv = cwp[j * LRW + 32 * ks + 8 * pq + jj]; tr[jj] = cwv * wr_[jj]; ti[jj] = cwv * wi_[jj]; }
              wrf[j][ks] = att::pack8(tr); wif[j][ks] = att::pack8(ti); } }
      float sr = 0.f, si = 0.f;
#pragma unroll 1
      for (int k0 = 0; k0 < 64; k0 += 32) { float tr_[32], ti_[32], tb_[32];
#pragma unroll
          for (int k = 0; k < 32; ++k) { tb_[k] = cbp[k0 + k]; tr_[k] = rw[(k0 + k) * 64]; ti_[k] = iw[(k0 + k) * 64]; }
#pragma unroll
          for (int k = 0; k < 32; ++k) { sr += tb_[k] * tr_[k]; si += tb_[k] * ti_[k]; } }
      rgb += sr; igb += si; }
    float la2; { const float lam = a.inp(I_LAMBDA)[ch]; const float sp = fmaxf(-lam, 0.f) + log1pf(__expf(-fabsf(lam))); la2 = -8.0f * sp * 1.4426950408889634f; }
    float cwo[5];
#pragma unroll
    for (int jj = 0; jj < 4; ++jj) cwo[jj] = a.inp(I_CONVW)[jj * LRW + g * 64 + j0 + c];
    cwo[4] = a.inp(I_CONVB)[g * 64 + j0 + c];
    asm volatile("" :: "v"(wrf[0][0]), "v"(wrf[1][0]), "v"(wrf[2][0]), "v"(wrf[3][0]), "v"(wrf[0][1]), "v"(wrf[1][1]), "v"(wrf[2][1]), "v"(wrf[3][1]));
    asm volatile("" :: "v"(wif[0][0]), "v"(wif[1][0]), "v"(wif[2][0]), "v"(wif[3][0]), "v"(wif[0][1]), "v"(wif[1][1]), "v"(wif[2][1]), "v"(wif[3][1]));
    asm volatile("" :: "v"(cwo[0]), "v"(cwo[1]), "v"(cwo[2]), "v"(cwo[3]), "v"(cwo[4]), "v"(rgb), "v"(igb), "v"(la2));
    asm volatile("s_waitcnt vmcnt(0)" ::: "memory");
    float hc = 0.f;
    if (wave == 0 && lane < 24) *(LAS u32x4*)(xb + lane * 16) = (u32x4){0u, 0u, 0u, 0u};
    asm volatile("s_waitcnt lgkmcnt(0)" ::: "memory");
    for (int st = 0; st < NSTEP; ++st) {
        const int buf = st & 1, p0 = st * (8 * WP) + WP * wave;
        if (st + 1 < NSTEP) LRU_DMA(p0 + 8 * WP, buf ^ 1);
        const LAS unsigned char* xs = xb + buf * XBUF;
        f32x4 rp[4], ip[4];
#pragma unroll
        for (int mt = 0; mt < 4; ++mt) { rp[mt] = (f32x4){0.f, 0.f, 0.f, 0.f}; ip[mt] = rp[mt]; }
#pragma unroll
        for (int mt = 0; mt < 4; ++mt) { const LAS unsigned char* ap = xs + (16 * (c >> 2) + 4 * mt + (c & 3)) * 128 + pq * 16;
            bf16x8 af[8];
#pragma unroll
            for (int q = 0; q < 8; ++q) af[q] = *(const LAS bf16x8*)(ap + (q >> 1) * 128 + (q & 1) * 64);
            asm volatile("" : "+v"(af[0]), "+v"(af[1]), "+v"(af[2]), "+v"(af[3]), "+v"(af[4]), "+v"(af[5]), "+v"(af[6]), "+v"(af[7]));
#pragma unroll
            for (int q = 0; q < 8; ++q) { rp[mt] = __builtin_amdgcn_mfma_f32_16x16x32_bf16(af[q], wrf[q >> 1][q & 1], rp[mt], 0, 0, 0); ip[mt] = __builtin_amdgcn_mfma_f32_16x16x32_bf16(af[q], wif[q >> 1][q & 1], ip[mt], 0, 0, 0); } }
        float av[16], bv[16]; float Al = 1.f, Hl = 0.f;
        { const LAS unsigned char* xo = xs + (16 * pq) * 128 + (j0 + c) * 2;
          unsigned xw[19];
#pragma unroll
          for (int q = 0; q < 19; ++q) xw[q] = *(const LAS bf16*)(xo + q * 128);
          asm volatile("" : "+v"(xw[0]), "+v"(xw[1]), "+v"(xw[2]), "+v"(xw[3]), "+v"(xw[4]), "+v"(xw[5]), "+v"(xw[6]), "+v"(xw[7]), "+v"(xw[8]), "+v"(xw[9]));
          asm volatile("" : "+v"(xw[10]), "+v"(xw[11]), "+v"(xw[12]), "+v"(xw[13]), "+v"(xw[14]), "+v"(xw[15]), "+v"(xw[16]), "+v"(xw[17]), "+v"(xw[18]));
#pragma unroll
          for (int idx = 0; idx < 16; ++idx) { const int mt = idx >> 2, r = idx & 3;
              const float w0 = __uint_as_float(xw[idx] << 16), w1 = __uint_as_float(xw[idx + 1] << 16), w2 = __uint_as_float(xw[idx + 2] << 16), w3 = __uint_as_float(xw[idx + 3] << 16);
              const float xcv = cwo[4] + (cwo[0] * w0 + cwo[1] * w1) + (cwo[2] * w2 + cwo[3] * w3);
              const float rr = __builtin_amdgcn_rcpf(1.f + __builtin_amdgcn_exp2f(-1.4426950408889634f * (rp[mt][r] + rgb))), ii = __builtin_amdgcn_rcpf(1.f + __builtin_amdgcn_exp2f(-1.4426950408889634f * (ip[mt][r] + igb)));
              const float aa = __builtin_amdgcn_exp2f(rr * la2);
              av[idx] = aa; bv[idx] = __builtin_amdgcn_sqrtf(fmaxf(1.f - aa * aa, 0.f)) * (ii * xcv);
              Hl = aa * Hl + bv[idx]; Al *= aa; } }
        float Ap = 1.f, Hp = 0.f;
#pragma unroll
        for (int k = 0; k < 3; ++k) { const float Ak = __shfl(Al, c + 16 * k), Hk = __shfl(Hl, c + 16 * k); if (k < pq) { Hp = Ak * Hp + Hk; Ap = Ap * Ak; } }
        typedef float f32x2 __attribute__((ext_vector_type(2)));
        if (pq == 3) *(LAS f32x2*)(lds + WT + ((buf * 8 + wave) * 16 + c) * 8) = (f32x2){Ap * Al, Al * Hp + Hl};
        asm volatile("s_waitcnt lgkmcnt(0)\n\ts_barrier" ::: "memory");
        if (st + 1 < NSTEP) asm volatile("s_waitcnt vmcnt(9)" ::: "memory"); else asm volatile("s_waitcnt vmcnt(0)" ::: "memory");
        float hin = hc;
        unsigned gw_[16];
#pragma unroll
        for (int q = 0; q < 16; ++q) gw_[q] = *(const LAS bf16*)(gb + (16 * pq + q) * 32 + c * 2);
        { f32x2 tw[8];
#pragma unroll
          for (int v = 0; v < 8; ++v) tw[v] = *(const LAS f32x2*)(lds + WT + ((buf * 8 + v) * 16 + c) * 8);
          asm volatile("" : "+v"(tw[0]), "+v"(tw[1]), "+v"(tw[2]), "+v"(tw[3]), "+v"(tw[4]), "+v"(tw[5]), "+v"(tw[6]), "+v"(tw[7]));
          asm volatile("" : "+v"(gw_[0]), "+v"(gw_[1]), "+v"(gw_[2]), "+v"(gw_[3]), "+v"(gw_[4]), "+v"(gw_[5]), "+v"(gw_[6]), "+v"(gw_[7]));
          asm volatile("" : "+v"(gw_[8]), "+v"(gw_[9]), "+v"(gw_[10]), "+v"(gw_[11]), "+v"(gw_[12]), "+v"(gw_[13]), "+v"(gw_[14]), "+v"(gw_[15]));
          float h = hc;
#pragma unroll
          for (int v = 0; v < 8; ++v) { if (v == wave) hin = h; h = tw[v].x * h + tw[v].y; }
          hc = h; }
        float h = Ap * hin + Hp;
        const size_t prow0 = (size_t)(p0 + 16 * pq); float smine = 0.f;
#pragma unroll
        for (int idx = 0; idx < 16; ++idx) {
            h = av[idx] * h + bv[idx];
            const float gr = __uint_as_float(gw_[idx] << 16);
            const float uu = 0.7978845608028654f * (gr + 0.044715f * gr * gr * gr);
            const float th = 1.f - 2.f * __builtin_amdgcn_rcpf(1.f + __builtin_amdgcn_exp2f(2.8853900817779268f * uu));
            const float y = h * (0.5f * gr * (1.f + th));
            Y[(prow0 + idx) * DM + c] = (bf16)f2bf(y);
            float s = y * y; s += dpp_f<0xB1>(s); s += dpp_f<0x4E>(s); s += dpp_f<0x141>(s); s += dpp_f<0x140>(s);
            if (c == idx) smine = s;
        }
        ssl[prow0 + c] = smine;
        if (st + 1 < NSTEP) { asm volatile("s_waitcnt lgkmcnt(0)" ::: "memory"); LRU_DMA_GR(p0 + 8 * WP); asm volatile("s_waitcnt vmcnt(16)" ::: "memory"); }
    }
#undef LRU_DMA
#undef LRU_DMA_GR
}
__device__ __forceinline__ void lru_phase(const Args& a, LAS unsigned char* lds, int wave, int lane, int G, int bx) {
    for (int it = bx; it < BATCH * 32; it += G) lru_item(a, lds, it / 32, it % 32, wave, lane);
    asm volatile("s_waitcnt vmcnt(0)" ::: "memory");
    __syncthreads();
}
}

constexpr int NPH = 9;
__device__ __forceinline__ Args kargs() {
    Args r{};
#if defined(__HIP_DEVICE_COMPILE__)
    static_assert(sizeof(Args) % 8 == 0, "Args is copied in 8-byte words");
    const __attribute__((address_space(4))) unsigned long long* q = (const __attribute__((address_space(4))) unsigned long long*)__builtin_amdgcn_kernarg_segment_ptr();
    unsigned long long* d = (unsigned long long*)&r;
#pragma unroll
    for (int i = 0; i < (int)(sizeof(Args) / 8); ++i) d[i] = q[i];
#endif
    return r;
}
__global__ void __launch_bounds__(NWAVES * 64, 2) fwd(Args args_unused) {
    extern __shared__ __attribute__((aligned(16))) unsigned char lds_[];
    LAS unsigned char* lds = (LAS unsigned char*)lds_;
    volatile LAS unsigned* MISC = (volatile LAS unsigned*)(lds + MISC_OFF);
    const int wave = __builtin_amdgcn_readfirstlane(threadIdx.x >> 6);
#define lane lane_id()
#define tid (wave * 64 + lane_id())
    const int G = gridDim.x; const int bx = blockIdx.x; const int vcu = (G % 8 == 0) ? (bx % 8) * (G / 8) + bx / 8 : bx;
    for (int u = threadIdx.x; u < (LDS_BYTES - LDSCTL_OFF) / 4; u += NWAVES * 64) ((LAS unsigned*)(lds + LDSCTL_OFF))[u] = 0u;
    __syncthreads();
    int lo, hi; unsigned* barw;
    { const Args a0 = kargs(); lo = a0.ph_lo; hi = a0.ph_hi; barw = (unsigned*)(a0.wsp() + WS_CTL) + CW_BAR + a0.li * XCD_BAR_WORDS; }
    const bool multi = (hi - lo) > 1;
    XcdBarrier bar; bar.bar = barw; bar.x = 0; bar.st = nullptr;
    if (multi) bar = xcd_barrier_post(barw, MISC + 8);
#define IN(k) (lo <= (k) && (k) < hi)
#define BOTH(k) (IN(k) && IN((k) + 1))
    if (IN(0)) { const Args args = kargs();     p0_adaln(args, lds, tid, G); if (BOTH(0)) xcd_barrier(bar, wave); }
    if (IN(1)) { const Args args = kargs();     p1_prep(args, lds, tid, lane, wave, vcu, G); if (BOTH(1)) xcd_barrier(bar, wave); }
    if (IN(2)) { const Args args = kargs();
        pg8::StaticOrder S; S.init(NTOK, DIN, G, bx, args.wsp() + WS_WINT, DM);
        pg8::EpiProj E{(bf16*)(args.wsp() + WS_PROJ)};
        pg8::gemm_phase<pg8::EpiProj, pg8::StaticOrder, true>(lds, args.wsp() + WS_XN, (unsigned)NTOK * DM * 2u, args.wsp() + WS_WINT, (unsigned)DIN * DM * 2u, DM * 2, S, E, wave);
        if (BOTH(2)) xcd_barrier(bar, wave);
    }
    if (IN(3)) { const Args args = kargs();
        lru::lru_phase(args, lds, wave, lane, G, bx);
        att::attn_phase(args, lds, wave, lane, G, bx);
        if (BOTH(3)) xcd_barrier(bar, wave);
    }
    if (IN(4)) { const Args args = kargs();
        pg8::StaticOrder S; S.init(NTOK, DM, G, bx, args.wsp() + WS_WOUTT, DM);
        LAS float* rst = (LAS float*)(lds + TAB_OFF);
        { const float* ssa = (const float*)(args.wsp() + WS_SSA); const float* ssl = (const float*)(args.wsp() + WS_SSL);
          for (int ui = 0; ui < 8; ++ui) { pg8::Unit u; if (!S.next(ui, u)) break;
              const int row = tid & 255, which = tid >> 8; const size_t grow = (size_t)u.pm * 256 + row; float s = 0.f;
              if (which == 0) { const f32x4 p0 = *(const f32x4*)(ssa + grow * 8), p1 = *(const f32x4*)(ssa + grow * 8 + 4); s = ((p0.x + p0.y) + (p0.z + p0.w)) + ((p1.x + p1.y) + (p1.z + p1.w)); }
              else { for (int q = 0; q < 32; ++q) s += ssl[(size_t)q * NTOK + grow]; }
              rst[(ui * 256 + row) * 2 + which] = rsqrtf(s * (1.f / 512.f) + EPS); } }
        __syncthreads();
        pg8::EpiOut E{args.inp(I_X), (const float*)(args.wsp() + WS_MOD), (bf16*)(args.wsp() + WS_X1B), (float*)(args.wsp() + WS_SSX), rst};
        pg8::gemm_phase<pg8::EpiOut, pg8::StaticOrder, true>(lds, (const unsigned char*)args.outp() + DO_Y, (unsigned)NTOK * DM * 2u, args.wsp() + WS_WOUTT, (unsigned)DM * DM * 2u, DM * 2, S, E, wave);
        if (BOTH(4)) xcd_barrier(bar, wave);
    }
    if (IN(5)) { const Args args = kargs();     p5_router(args, lds, tid, lane, wave, G); if (BOTH(5)) xcd_barrier(bar, wave); }
    if (IN(6)) { const Args args = kargs();
        const pg8::MoeTables T = pg8::moe_tables(lds + TAB_OFF, (const unsigned*)(args.wsp() + WS_CTL) + CW_CNT, tid);
        pg8::MoeOrder S{(const char*)(args.wsp() + WS_WGU), 8, 2, T, bx % 8, bx / 8, G / 8, 0};
        S.load_entries((const int*)(args.wsp() + WS_LIST), nullptr, tid);
        pg8::EpiGU E{T.ent, args.inp(I_BG), args.inp(I_BU), args.wsp() + WS_ACT, (LAS const float*)(lds + BIAS_OFF)};
        pg8::gemm_phase<pg8::EpiGU, pg8::MoeOrder, true>(lds, (const unsigned char*)args.outp() + DO_H2, (unsigned)NTOK * DM, args.wsp() + WS_WGU, (unsigned)NE * 2u * DE * DM, DM, S, E, wave);
        if (BOTH(6)) xcd_barrier(bar, wave);
    }
    if (IN(7)) { const Args args = kargs();
        const pg8::MoeTables T = pg8::moe_tables(lds + TAB_OFF, (const unsigned*)(args.wsp() + WS_CTL) + CW_CNT, tid);
        pg8::MoeOrder S{(const char*)(args.wsp() + WS_WDT), 4, 0, T, bx % 8, bx / 8, G / 8, 1};
        S.load_entries((const int*)(args.wsp() + WS_LIST), (const float*)(args.wsp() + WS_PASG), tid);
        pg8::EpiDown E{T.ent, args.inp(I_BD), T.pw, (unsigned char*)args.outp(), (LAS const float*)(lds + BIAS_OFF)};
        pg8::gemm_phase<pg8::EpiDown, pg8::MoeOrder, true>(lds, args.wsp() + WS_ACT, (unsigned)NASG * DE, args.wsp() + WS_WDT, (unsigned)NE * DM * DE, DE, S, E, wave);
        if (BOTH(7)) xcd_barrier(bar, wave);
    }
    if (IN(8)) { const Args args = kargs();     p8_final(args, lane, wave, vcu, G); }
#undef IN
#undef BOTH
#undef lane
#undef tid
}

extern "C" void kernel_launch(void* const* d_in, const int* in_sizes, int n_in, void* d_out, int out_size, void* d_ws, size_t ws_size, hipStream_t stream) {
    static int grid = 0;
    if (grid == 0) {
        if (n_in != 26 || out_size != NTOK * DM || ws_size < WS_END) { fprintf(stderr, "kernel_launch: unexpected shapes (n_in %d out %d ws %zu)\n", n_in, out_size, ws_size); grid = -1; return; }
        int dev = 0, cus = 0;
        if (hipGetDevice(&dev) != hipSuccess || hipDeviceGetAttribute(&cus, hipDeviceAttributeMultiprocessorCount, dev) != hipSuccess) { grid = -1; return; }
        if (hipFuncSetAttribute((const void*)fwd, hipFuncAttributeMaxDynamicSharedMemorySize, LDS_BYTES) != hipSuccess) { grid = -1; return; }
        int per_cu = 0;
        (void)hipOccupancyMaxActiveBlocksPerMultiprocessor(&per_cu, (const void*)fwd, NWAVES * 64, LDS_BYTES);
        (void)hipGetLastError();
        grid = cus;
    }
    if (grid < 0) return;
    (void)hipMemsetAsync((char*)d_ws + WS_CTL, 0, CTL_ZERO_BYTES, stream);
    Args a{};
    for (int i = 0; i < 26; ++i) a.in[i] = (KGAS const float*)d_in[i];
    a.out = (KGAS float*)d_out; a.ws = (KGAS unsigned char*)d_ws;
    a.ph_lo = 0; a.ph_hi = NPH; a.li = 0; a.pad = 0;
    hipLaunchKernelGGL(fwd, dim3(grid), dim3(NWAVES * 64), LDS_BYTES, stream, a);
}
```

```cpp
#include <hip/hip_runtime.h>
#include <cstdio>
#include <cstdint>

constexpr int BATCH = 8, SEQ = 4096, DM = 1024, NTOK = BATCH * SEQ;
constexpr int DIN = 2560, SBW = 512, LRW = 512, NH = 8, HD = 64;
constexpr int NE = 32, TOPK = 4, NASG = NTOK * TOPK, DE = 1024;
constexpr float EPS = 1e-6f;
constexpr float C2 = 0.125f * 1.4426950408889634f;
constexpr float LN2 = 0.6931471805599453f;

constexpr size_t MiB = 1u << 20;
constexpr size_t WS_CTL = 0, CTL_ZERO_BYTES = 1 * MiB;
constexpr size_t WS_MOD = 1 * MiB;
constexpr size_t WS_WR = 1 * MiB + 256 * 1024;
constexpr size_t WS_PASG = 1 * MiB + 512 * 1024;
constexpr size_t WS_SSA = 2 * MiB;
constexpr size_t WS_SSL = 3 * MiB;
constexpr size_t WS_SSX = 7 * MiB;
constexpr size_t WS_LIST = 9 * MiB;
constexpr size_t WS_RA = 18 * MiB;
constexpr size_t WS_XN = WS_RA, WS_PROJ = WS_RA + 64 * MiB, WS_WINT = WS_RA + 224 * MiB, WS_WOUTT = WS_RA + 229 * MiB, WS_ACT = WS_RA;
constexpr size_t WS_RB = WS_RA + 256 * MiB;
constexpr size_t WS_WGU = WS_RB;
constexpr size_t WS_WDT = WS_RB + 128 * MiB;
constexpr size_t WS_X1B = WS_WDT + 64 * MiB;
constexpr size_t WS_END = WS_X1B + 64 * MiB;
constexpr size_t PROJ_STRIDE = (size_t)NTOK * 512;
constexpr size_t DO_Y = 0, DO_H2 = 64 * MiB;
constexpr int CW_CNT = 64;
constexpr int CW_BAR = 4096;

typedef unsigned short bf16;
typedef unsigned u32x4 __attribute__((ext_vector_type(4)));
typedef float f32x4 __attribute__((ext_vector_type(4)));

__device__ __forceinline__ float bf2f(bf16 v) { return __uint_as_float((unsigned)v << 16); }
__device__ __forceinline__ unsigned f2bf(float f) { unsigned u = __float_as_uint(f); return (u + 0x7fffu + ((u >> 16) & 1u)) >> 16; }
__device__ __forceinline__ unsigned pk2(float lo, float hi) { return f2bf(lo) | (f2bf(hi) << 16); }
__device__ __forceinline__ unsigned pk4_fp8(float a, float b, float c, float d) {
    a = fminf(fmaxf(a, -448.f), 448.f); b = fminf(fmaxf(b, -448.f), 448.f); c = fminf(fmaxf(c, -448.f), 448.f); d = fminf(fmaxf(d, -448.f), 448.f);
    int r = 0; r = __builtin_amdgcn_cvt_pk_fp8_f32(a, b, r, false); r = __builtin_amdgcn_cvt_pk_fp8_f32(c, d, r, true); return (unsigned)r; }
__device__ __forceinline__ unsigned pk4_fp8_raw(float a, float b, float c, float d) {
    int r = 0; r = __builtin_amdgcn_cvt_pk_fp8_f32(a, b, r, false); r = __builtin_amdgcn_cvt_pk_fp8_f32(c, d, r, true); return (unsigned)r; }
__device__ __forceinline__ unsigned pk4_fp8_m3(float a, float b, float c, float d) {
    a = __builtin_amdgcn_fmed3f(a, -448.f, 448.f); b = __builtin_amdgcn_fmed3f(b, -448.f, 448.f); c = __builtin_amdgcn_fmed3f(c, -448.f, 448.f); d = __builtin_amdgcn_fmed3f(d, -448.f, 448.f);
    int r = 0; r = __builtin_amdgcn_cvt_pk_fp8_f32(a, b, r, false); r = __builtin_amdgcn_cvt_pk_fp8_f32(c, d, r, true); return (unsigned)r; }
constexpr float W8_SCALE = 1.f;
__device__ __forceinline__ float sigmoidf_(float x) { return 1.f / (1.f + __expf(-x)); }
__device__ __forceinline__ float gelu_tanh(float x) { const float u = 0.7978845608028654f * (x + 0.044715f * x * x * x); return 0.5f * x * (1.f + tanhf(u)); }
__device__ __forceinline__ void unpack8(const u32x4 v, float* f) {
    f[0] = __uint_as_float(v.x << 16); f[1] = __uint_as_float(v.x & 0xffff0000u); f[2] = __uint_as_float(v.y << 16); f[3] = __uint_as_float(v.y & 0xffff0000u);
    f[4] = __uint_as_float(v.z << 16); f[5] = __uint_as_float(v.z & 0xffff0000u); f[6] = __uint_as_float(v.w << 16); f[7] = __uint_as_float(v.w & 0xffff0000u);
}
__device__ __forceinline__ float dot8(const u32x4 a, const u32x4 b) {
    float x[8], y[8]; unpack8(a, x); unpack8(b, y); float s = 0.f;
#pragma unroll
    for (int i = 0; i < 8; ++i) s += x[i] * y[i];
    return s;
}

#if defined(__HIP_DEVICE_COMPILE__)
#define KGAS __attribute__((address_space(1)))
#else
#define KGAS
#endif
struct Args {
    KGAS const float* in[26]; KGAS float* out; KGAS unsigned char* ws; int ph_lo, ph_hi, li, pad;
    __host__ __device__ __forceinline__ const float* inp(int i) const { return (const float*)in[i]; }
    __host__ __device__ __forceinline__ float* outp() const { return (float*)out; }
    __host__ __device__ __forceinline__ unsigned char* wsp() const { return (unsigned char*)ws; }
};
enum { I_X = 0, I_C, I_ADAW, I_ADAB, I_MIXG, I_WIN, I_CONVW, I_CONVB, I_RGW, I_RGB, I_IGW, I_IGB, I_LAMBDA, I_AOG, I_LOG, I_WOUT, I_FFNG, I_RW, I_RB, I_WG, I_BG, I_WU, I_BU, I_WD, I_BD, I_FING };

#define GAS __attribute__((address_space(1)))
#define LAS __attribute__((address_space(3)))
typedef GAS unsigned gu32;
#define RLX_AGENT __ATOMIC_RELAXED, __HIP_MEMORY_SCOPE_AGENT
#define LDS_WAIT() asm volatile("s_waitcnt lgkmcnt(0)" ::: "memory")
#define VM_WAIT() asm volatile("s_waitcnt vmcnt(0)" ::: "memory")
constexpr int NWAVES = 8;
constexpr int RING_BYTES = 131072, TAB_OFF = RING_BYTES, LDS_BYTES = 161792, LDSCTL_OFF = LDS_BYTES - 512, MISC_OFF = LDSCTL_OFF + 320, BIAS_OFF = LDSCTL_OFF - 2048;

#define XB_TMO      128
#define XB_XCNT(j)  (256  + 64 * (j))
#define XB_XSUB(j)  (1280 + 64 * (j))
#define XB_XGEN(j)  (2304 + 64 * (j))
#define XB_TOP      3328
#define XB_TOPGEN   3392
#define XCD_BAR_WORDS 3456
#define XB_SPIN_CAP (1u << 18)
__device__ __forceinline__ unsigned xb_ld(unsigned* p)              { return __hip_atomic_load(p, __ATOMIC_RELAXED, __HIP_MEMORY_SCOPE_AGENT); }
__device__ __forceinline__ unsigned xb_add(unsigned* p, unsigned v) { return __hip_atomic_fetch_add(p, v, __ATOMIC_RELAXED, __HIP_MEMORY_SCOPE_AGENT); }
__device__ __forceinline__ unsigned xb_xcc_id() { return (unsigned)__builtin_amdgcn_s_getreg((3 << 11) | 20) & 0xFu; }
#define XB_SPIN(cond, bar) do { unsigned _sp = 0; while (cond) { __builtin_amdgcn_s_sleep(1); \
    if ((++_sp & 255u) == 0u) { if (xb_ld(&(bar)[XB_TMO])) break; if (_sp > XB_SPIN_CAP) { atomicAdd(&(bar)[XB_TMO], 1u); break; } } } } while (0)
struct XcdBarrier { unsigned* bar; unsigned x; volatile LAS unsigned* st; };
__device__ __forceinline__ XcdBarrier xcd_barrier_post(unsigned* bar, volatile LAS unsigned* st) {
    XcdBarrier b; b.bar = bar; b.x = xb_xcc_id(); b.st = st;
    if (threadIdx.x == 0) (void)xb_add(&bar[XB_XCNT(b.x)], 1u);
    return b;
}
__device__ __forceinline__ void xcd_barrier_complete(unsigned* bar, unsigned x, unsigned& nloc, unsigned& nx) {
    const unsigned G = gridDim.x * gridDim.y * gridDim.z;
    unsigned sum, cnt, mine, sp = 0u;
    for (;;) {
        sum = 0u; cnt = 0u; mine = 0u;
#pragma unroll
        for (unsigned j = 0; j < 16; ++j) { const unsigned c = xb_ld(&bar[XB_XCNT(j)]); sum += c; cnt += (c > 0u) ? 1u : 0u; mine = (j == x) ? c : mine; }
        if (sum == G) break;
        __builtin_amdgcn_s_sleep(1);
        if ((++sp & 255u) == 0u) { if (xb_ld(&bar[XB_TMO])) break; if (sp > XB_SPIN_CAP) { atomicAdd(&bar[XB_TMO], 1u); break; } }
    }
    nloc = mine > 0u ? mine : 1u; nx = cnt > 0u ? cnt : 1u;
}
__device__ __forceinline__ int lane_id();
__device__ __forceinline__ void xcd_barrier(const XcdBarrier& b, const int wave_) {
    asm volatile("s_waitcnt vmcnt(0)" ::: "memory");
    __syncthreads();
    if (wave_ == 0 && lane_id() == 0) {
        unsigned* bar = b.bar;
        __builtin_amdgcn_s_waitcnt(0);
        unsigned nloc = b.st[0], nx = b.st[1];
        if (nloc == 0u) { xcd_barrier_complete(bar, b.x, nloc, nx); b.st[0] = nloc; b.st[1] = nx; }
        const unsigned old = xb_add(&bar[XB_XSUB(b.x)], 1u);
        const unsigned gen = old / nloc;
        if (old + 1u == (gen + 1u) * nloc) {
            __builtin_amdgcn_fence(__ATOMIC_RELEASE, "agent");
            asm volatile("s_waitcnt vmcnt(0)" ::: "memory");
            const unsigned og = xb_add(&bar[XB_TOP], 1u);
            const unsigned tg = og / nx;
            if (og + 1u == (tg + 1u) * nx) xb_add(&bar[XB_TOPGEN], 1u);
            else XB_SPIN(xb_ld(&bar[XB_TOPGEN]) == tg, bar);
            __builtin_amdgcn_fence(__ATOMIC_ACQUIRE, "agent");
            xb_add(&bar[XB_XGEN(b.x)], 1u);
            asm volatile("s_waitcnt vmcnt(0)" ::: "memory");
        } else {
            XB_SPIN(xb_ld(&bar[XB_XGEN(b.x)]) == gen, bar);
            __builtin_amdgcn_fence(__ATOMIC_ACQUIRE, "agent");
            asm volatile("s_waitcnt vmcnt(0)" ::: "memory");
        }
    }
    __syncthreads();
}

__device__ __forceinline__ int lane_id() { int r; asm volatile("v_mbcnt_lo_u32_b32 %0, -1, 0\n\tv_mbcnt_hi_u32_b32 %0, -1, %0" : "=v"(r)); return r; }
__device__ __forceinline__ float wave_sum(float v) {
#pragma unroll
    for (int o = 1; o < 64; o <<= 1) v += __shfl_xor(v, o);
    return v;
}

__device__ __forceinline__ void p0_adaln(const Args& a, LAS unsigned char* lds, int tid, int G) {
    LAS float* cact = (LAS float*)lds;
    LAS float* part = (LAS float*)(lds + 32768);
    const float* c = a.inp(I_C);
    for (int i = tid; i < 8 * 1024; i += 512) { const int b = i >> 10, k = i & 1023; const float v = c[i]; cact[k * 8 + b] = v / (1.f + __expf(-v)); }
    __syncthreads();
    const float* W = a.inp(I_ADAW); float* mod = (float*)(a.wsp() + WS_MOD);
    const int col = tid % 24, ks = tid / 24;
    for (int ch = blockIdx.x; ch < 6144 / 24; ch += G) {
        const int n = ch * 24 + col;
        if (ks < 21) {
            float acc[8];
#pragma unroll
            for (int b = 0; b < 8; ++b) acc[b] = 0.f;
#pragma unroll 7
            for (int k = ks; k < 1024; k += 21) {
                const float w = W[(size_t)k * 6144 + n];
                const f32x4 c0 = *(const LAS f32x4*)(cact + k * 8), c1 = *(const LAS f32x4*)(cact + k * 8 + 4);
                acc[0] += w * c0.x; acc[1] += w * c0.y; acc[2] += w * c0.z; acc[3] += w * c0.w;
                acc[4] += w * c1.x; acc[5] += w * c1.y; acc[6] += w * c1.z; acc[7] += w * c1.w;
            }
#pragma unroll
            for (int b = 0; b < 8; ++b) part[(ks * 24 + col) * 8 + b] = acc[b];
        }
        __syncthreads();
        if (tid < 192) { const int cc = tid >> 3, b = tid & 7; float s = a.inp(I_ADAB)[ch * 24 + cc];
            for (int q = 0; q < 21; ++q) s += part[(q * 24 + cc) * 8 + b];
            mod[b * 6144 + ch * 24 + cc] = s; }
        __syncthreads();
    }
}

struct P1Item { const float* W; const float* ks; unsigned char* dst; int N, k0, n0, e8, which, fp8; };
__device__ __forceinline__ P1Item p1_decode(const Args& a, int it) {
    constexpr int I_IN = 16 * (DIN / 256), I_OUT = 16 * 4, I_EXP = 8 * 4;
    P1Item d; d.ks = nullptr; d.fp8 = 0; d.e8 = 0; d.which = 0;
    if (it < I_IN) { const int nb = DIN / 256; d.W = a.inp(I_WIN); d.N = DIN; d.k0 = 64 * (it / nb); d.n0 = 256 * (it % nb); d.dst = a.wsp() + WS_WINT; return d; }
    it -= I_IN;
    if (it < I_OUT) { d.W = a.inp(I_WOUT); d.N = DM; d.k0 = 64 * (it / 4); d.n0 = 256 * (it % 4); d.dst = a.wsp() + WS_WOUTT;
        d.ks = (d.k0 < 512) ? a.inp(I_AOG) : (a.inp(I_LOG) - 512); return d; }
    it -= I_OUT;
    const int mat = it / I_EXP, q = it % I_EXP, e = mat / 3; d.which = mat % 3;
    d.k0 = 128 * (q / 4); d.n0 = 256 * (q % 4); d.fp8 = 1; d.N = 1024; d.e8 = e;
    if (d.which == 2) { d.W = a.inp(I_WD) + (size_t)e * DE * DM; d.dst = a.wsp() + WS_WDT; }
    else { d.W = a.inp(d.which == 0 ? I_WG : I_WU) + (size_t)e * DM * DE; d.dst = a.wsp() + WS_WGU; }
    return d;
}
__device__ __forceinline__ void p1_prep(const Args& a, LAS unsigned char* lds, int tid, int lane, int wave, int vcu, int G) {
    constexpr int NIT = 16 * (DIN / 256) + 16 * 4 + 96 * 8 * 4;
    const int col4 = (tid & 63) * 4, rb = tid >> 6;
    f32x4 tv[16];
    P1Item cur = p1_decode(a, (int)blockIdx.x < NIT ? (int)blockIdx.x : 0);
#define P1_LOAD(d) do { _Pragma("unroll") for (int i = 0; i < 16; ++i) { int kk_ = (d).k0 + rb + 8 * i; kk_ = kk_ < 1023 ? kk_ : 1023;     \
        tv[i] = *(const f32x4*)((d).W + (size_t)kk_ * (d).N + (d).n0 + col4); } } while (0)
    if ((int)blockIdx.x < NIT) P1_LOAD(cur);
    int buf = 0;
    for (int it = blockIdx.x; it < NIT; it += G) {
        LAS unsigned char* T = lds + buf * 32768;
        if (cur.fp8) {
#pragma unroll
            for (int i = 0; i < 16; ++i) *(LAS unsigned*)(T + (rb + 8 * i) * 256 + col4) = pk4_fp8(tv[i].x * W8_SCALE, tv[i].y * W8_SCALE, tv[i].z * W8_SCALE, tv[i].w * W8_SCALE);
        } else {
#pragma unroll
            for (int i = 0; i < 8; ++i) { f32x4 v = tv[i]; if (cur.ks) v = v * cur.ks[cur.k0 + rb + 8 * i];
                typedef unsigned u32x2 __attribute__((ext_vector_type(2))); *(LAS u32x2*)(T + (rb + 8 * i) * 512 + col4 * 2) = (u32x2){pk2(v.x, v.y), pk2(v.z, v.w)}; }
        }
        const P1Item me = cur;
        const int itn = it + G;
        if (itn < NIT) { cur = p1_decode(a, itn); P1_LOAD(cur); }
        __syncthreads();
        { const int n = tid & 255, hf = tid >> 8, ng = me.n0 + n;
          u32x4 o[4];
          if (me.fp8) {
#pragma unroll
              for (int q = 0; q < 4; ++q) { unsigned w4[4];
#pragma unroll
                  for (int r = 0; r < 4; ++r) { const LAS unsigned char* p = T + (hf * 64 + q * 16 + r * 4) * 256 + n;
                      w4[r] = (unsigned)p[0] | ((unsigned)p[256] << 8) | ((unsigned)p[512] << 16) | ((unsigned)p[768] << 24); }
                  o[q] = (u32x4){w4[0], w4[1], w4[2], w4[3]}; }
              const size_t orow = (me.which == 2) ? (size_t)me.e8 * DM + ng : (size_t)(me.e8 * 8 + ng / 128) * 256 + (ng % 128) + (me.which ? 128 : 0);
              u32x4* dp = (u32x4*)(me.dst + orow * DM + me.k0 + hf * 64);
#pragma unroll
              for (int q = 0; q < 4; ++q) dp[q] = o[q];
          } else {
#pragma unroll
              for (int q = 0; q < 4; ++q) { unsigned w4[4];
#pragma unroll
                  for (int r = 0; r < 4; ++r) { const LAS unsigned short* p = (const LAS unsigned short*)(T + (hf * 32 + q * 8 + r * 2) * 512 + n * 2);
                      w4[r] = (unsigned)p[0] | ((unsigned)p[256] << 16); }
                  o[q] = (u32x4){w4[0], w4[1], w4[2], w4[3]}; }
              u32x4* dp = (u32x4*)((bf16*)me.dst + (size_t)ng * DM + me.k0 + hf * 32);
#pragma unroll
              for (int q = 0; q < 4; ++q) dp[q] = o[q];
          } }
        buf ^= 1;
    }
#undef P1_LOAD
    __syncthreads();
    const int gw = vcu * NWAVES + wave, NGW = G * NWAVES;
    { bf16* wr = (bf16*)(a.wsp() + WS_WR);
      for (int i = blockIdx.x * 512 + tid; i < 32 * 1024; i += G * 512) { const int e = i >> 10, k = i & 1023; const float w = a.inp(I_RW)[k * 32 + e];
          const unsigned hi = f2bf(w); wr[i] = (bf16)hi; wr[32768 + i] = (bf16)f2bf(w - __uint_as_float(hi << 16)); } }
    const float* mod = (const float*)(a.wsp() + WS_MOD);
    f32x4 v0[4], v1[4], w0[4], w1[4];
    if (gw < NTOK) {
#pragma unroll
        for (int j = 0; j < 4; ++j) { v0[j] = ((const f32x4*)(a.inp(I_X) + (size_t)gw * DM) + lane)[64 * j]; v1[j] = ((const f32x4*)(a.inp(I_X) + (size_t)(gw + NGW < NTOK ? gw + NGW : gw) * DM) + lane)[64 * j]; }
    }
    for (int m0 = gw; m0 < NTOK; m0 += 2 * NGW) {
        const int m1 = m0 + NGW; const bool two = m1 < NTOK;
        const int n0 = m0 + 2 * NGW, n1 = n0 + NGW;
        if (n0 < NTOK) {
#pragma unroll
            for (int j = 0; j < 4; ++j) { w0[j] = ((const f32x4*)(a.inp(I_X) + (size_t)n0 * DM) + lane)[64 * j]; w1[j] = ((const f32x4*)(a.inp(I_X) + (size_t)(n1 < NTOK ? n1 : n0) * DM) + lane)[64 * j]; }
        }
        float s0 = 0.f, s1 = 0.f;
#pragma unroll
        for (int j = 0; j < 4; ++j) { s0 += (v0[j].x * v0[j].x + v0[j].y * v0[j].y) + (v0[j].z * v0[j].z + v0[j].w * v0[j].w); s1 += (v1[j].x * v1[j].x + v1[j].y * v1[j].y) + (v1[j].z * v1[j].z + v1[j].w * v1[j].w); }
        const float rs0 = rsqrtf(wave_sum(s0) * (1.f / DM) + EPS), rs1 = rsqrtf(wave_sum(s1) * (1.f / DM) + EPS);
#pragma unroll
        for (int q = 0; q < 2; ++q) { if (q == 1 && !two) break;
            const int m = q ? m1 : m0; const int b = m / SEQ; const float rs = q ? rs1 : rs0;
            unsigned long long* o8 = (unsigned long long*)((bf16*)(a.wsp() + WS_XN) + (size_t)m * DM) + lane;
#pragma unroll
            for (int j = 0; j < 4; ++j) {
                const int k = 4 * lane + 256 * j;
                const f32x4 g = *(const f32x4*)(a.inp(I_MIXG) + k), sh = *(const f32x4*)(mod + b * 6144 + k), sc = *(const f32x4*)(mod + b * 6144 + 1024 + k);
                const f32x4 h = ((q ? v1[j] : v0[j]) * rs * g) * (sc + 1.f) + sh;
                o8[64 * j] = (unsigned long long)pk2(h.x, h.y) | ((unsigned long long)pk2(h.z, h.w) << 32);
            } }
#pragma unroll
        for (int j = 0; j < 4; ++j) { v0[j] = w0[j]; v1[j] = w1[j]; }
    }
}

__device__ __forceinline__ void p8_final(const Args& a, int lane, int wave, int vcu, int G) {
    typedef float f32x2 __attribute__((ext_vector_type(2)));
    const int gw = vcu * NWAVES + wave, NGW = G * NWAVES;
    const float* mod = (const float*)(a.wsp() + WS_MOD);
    u32x4 cx[2], cy[4], nx[2], ny[4];
#define P8_LOAD(m_, X, Y) do { const u32x4* x1_ = (const u32x4*)((const bf16*)(a.wsp() + WS_X1B) + (size_t)(m_) * DM) + 2 * lane; const u32x4* y_ = (const u32x4*)((const unsigned char*)a.outp() + (size_t)(m_) * 4096) + lane; \
        X[0] = x1_[0]; X[1] = x1_[1]; Y[0] = y_[0]; Y[1] = y_[64]; Y[2] = y_[128]; Y[3] = y_[192]; } while (0)
    if (gw < NTOK) P8_LOAD(gw, cx, cy);
    for (int m = gw; m < NTOK; m += NGW) {
        const int b = m / SEQ; const int mn = m + NGW;
        if (mn < NTOK) P8_LOAD(mn, nx, ny);
        float v[16], xv[16]; float s = 0.f;
        unpack8(cx[0], xv); unpack8(cx[1], xv + 8);
        const float* gp = mod + b * 6144 + 5120 + 16 * lane;
#pragma unroll
        for (int q = 0; q < 4; ++q) {
            const unsigned w0 = cy[0][q], w1 = cy[1][q], w2 = cy[2][q], w3 = cy[3][q];
            const f32x2 a0 = __builtin_amdgcn_cvt_pk_f32_fp8((int)w0, false), a1 = __builtin_amdgcn_cvt_pk_f32_fp8((int)w0, true), b0 = __builtin_amdgcn_cvt_pk_f32_fp8((int)w1, false), b1 = __builtin_amdgcn_cvt_pk_f32_fp8((int)w1, true);
            const f32x2 c0 = __builtin_amdgcn_cvt_pk_f32_fp8((int)w2, false), c1 = __builtin_amdgcn_cvt_pk_f32_fp8((int)w2, true), d0 = __builtin_amdgcn_cvt_pk_f32_fp8((int)w3, false), d1 = __builtin_amdgcn_cvt_pk_f32_fp8((int)w3, true);
            const f32x4 g = *(const f32x4*)(gp + 4 * q);
            const float y0 = (a0.x + b0.x) + (c0.x + d0.x), y1 = (a0.y + b0.y) + (c0.y + d0.y), y2 = (a1.x + b1.x) + (c1.x + d1.x), y3 = (a1.y + b1.y) + (c1.y + d1.y);
            const float t0 = xv[4 * q] + g.x * y0, t1 = xv[4 * q + 1] + g.y * y1, t2 = xv[4 * q + 2] + g.z * y2, t3 = xv[4 * q + 3] + g.w * y3;
            v[4 * q] = t0; v[4 * q + 1] = t1; v[4 * q + 2] = t2; v[4 * q + 3] = t3; s += (t0 * t0 + t1 * t1) + (t2 * t2 + t3 * t3);
        }
        const float rs = rsqrtf(wave_sum(s) * (1.f / DM) + EPS);
        f32x4* o = (f32x4*)(a.outp() + (size_t)m * DM) + 4 * lane;
#pragma unroll
        for (int q = 0; q < 4; ++q) { const f32x4 f = *(const f32x4*)(a.inp(I_FING) + 16 * lane + 4 * q);
            o[q] = (f32x4){v[4 * q] * rs * f.x, v[4 * q + 1] * rs * f.y, v[4 * q + 2] * rs * f.z, v[4 * q + 3] * rs * f.w}; }
#pragma unroll
        for (int j = 0; j < 2; ++j) cx[j] = nx[j];
#pragma unroll
        for (int j = 0; j < 4; ++j) cy[j] = ny[j];
    }
#undef P8_LOAD
}

__device__ __forceinline__ void glds16(const void* gsrc, unsigned lds_dst) { unsigned keep;
    asm volatile("s_mov_b32 %0, m0\n\ts_mov_b32 m0, %2\n\ts_nop 0\n\tglobal_load_lds_dwordx4 %1, off\n\ts_mov_b32 m0, %0" : "=&s"(keep) : "v"(gsrc), "s"(lds_dst) : "memory"); }
__device__ __forceinline__ unsigned lds_addr(const LAS void* p) { return (unsigned)__builtin_amdgcn_readfirstlane((int)(unsigned)(unsigned long long)p); }

namespace pg8 {
#define PG8_LAS __attribute__((address_space(3)))
typedef short bf16x8 __attribute__((ext_vector_type(8)));
typedef int v4i __attribute__((ext_vector_type(4)));
typedef int v8i __attribute__((ext_vector_type(8)));
constexpr int BM = 256, BK = 64, HALF = 128, HTB = HALF * BK * 2, STAGE_BYTES = 8 * HTB, NXCD = 8, WGM = 8;
__host__ __device__ __forceinline__ int lds_byte(int r, int c) { const int st = (r >> 4) * 2 + (c >> 5), rr = r & 15, cc = c & 31, ob = rr * 64 + cc * 2; return st * 1024 + (ob ^ (((ob >> 9) & 1) << 5)); }
__host__ __device__ __forceinline__ void stage_rc(int b, int& R, int& C) { const int st = b / 1024, sb = b % 1024, swz = sb ^ (((sb >> 9) & 1) << 5); R = (st >> 1) * 16 + swz / 64; C = (st & 1) * 32 + (swz % 64) / 2; }
__host__ __device__ __forceinline__ int perm32(int rho) { const int n = rho >> 4, i = rho & 15; return 8 * (i >> 2) + 4 * n + (i & 3); }
__device__ __forceinline__ unsigned cvt_pk_bf16(float lo, float hi) { unsigned r; asm volatile("v_cvt_pk_bf16_f32 %0, %1, %2" : "=v"(r) : "v"(lo), "v"(hi)); return r; }

struct Unit { int pm, pn, e, nrows, slot; };

template <class Epi, class Sched, bool ALIGN_EPI>
__device__ __forceinline__ void gemm_phase(PG8_LAS unsigned char* lds, const void* Abase, unsigned Abytes, const void* Bbase, unsigned Bbytes, const int RB  ,
                                           const Sched& S, const Epi& E, const int wid) {
    const int lane = lane_id(), tid = wid * 64 + lane, wr = wid >> 2, wc = wid & 3, fr = lane & 15, fq = lane >> 4;
    const int nt = RB / 128;
    int R0, C0; stage_rc(tid * 16, R0, C0);
    const unsigned cb2 = (unsigned)C0 * 2u;
    const unsigned voffB = (unsigned)((Epi::PERM ? ((R0 & ~31) + perm32(R0 & 31)) : R0) * RB) + cb2;
    const __amdgpu_buffer_rsrc_t rsA = __builtin_amdgcn_make_buffer_rsrc((void*)Abase, 0, Abytes, 0x00020000);
    const __amdgpu_buffer_rsrc_t rsB = __builtin_amdgcn_make_buffer_rsrc((void*)Bbase, 0, Bbytes, 0x00020000);
    const unsigned hstep = (unsigned)HALF * RB;
    const unsigned ldsw = (unsigned)wid * 1024u;
    const int aoff = lds_byte(wr * 64 + fr, fq * 8), boff = lds_byte(wc * 32 + fr, fq * 8);
#define PG8_SA(b, h) (((b) * 2 + (h)) * HTB)
#define PG8_SB(b, h) ((4 + (b) * 2 + (h)) * HTB)
#define PG8_STAGE_B(bufoff, soff) do { _Pragma("unroll") for (int _i = 0; _i < 2; ++_i) \
        __builtin_amdgcn_raw_ptr_buffer_load_lds(rsB, (PG8_LAS void*)(lds + (bufoff) + ldsw + _i * 8192), 16, voffB, (soff) + (unsigned)(_i * 64 * RB), 0, 0); } while (0)
#define PG8_STAGE_A(bufoff, un, h, soff) do { _Pragma("unroll") for (int _i = 0; _i < 2; ++_i) \
        __builtin_amdgcn_raw_ptr_buffer_load_lds(rsA, (PG8_LAS void*)(lds + (bufoff) + ldsw + _i * 8192), 16, S.arow_off((un), (h) * HALF + R0 + 64 * _i) + cb2, (soff), 0, 0); } while (0)
#define PG8_LDA(dst, b, h) do { _Pragma("unroll") for (int m = 0; m < 4; ++m) _Pragma("unroll") for (int k = 0; k < 2; ++k) dst[m][k] = *(const PG8_LAS bf16x8*)(lds + PG8_SA(b, h) + aoff + m * 2048 + k * 1024); } while (0)
#define PG8_LDB(dst, b, h) do { _Pragma("unroll") for (int n = 0; n < 2; ++n) _Pragma("unroll") for (int k = 0; k < 2; ++k) dst[n][k] = *(const PG8_LAS bf16x8*)(lds + PG8_SB(b, h) + boff + n * 2048 + k * 1024); } while (0)
#define PG8_MMA(ai, bj, At, Bt) do { __builtin_amdgcn_s_setprio(1); _Pragma("unroll") for (int m = 0; m < 4; ++m) _Pragma("unroll") for (int n = 0; n < 2; ++n) _Pragma("unroll") for (int k = 0; k < 2; ++k) \
        acc[ai][bj][m][n] = __builtin_amdgcn_mfma_f32_16x16x32_bf16(Bt[n][k], At[m][k], acc[ai][bj][m][n], 0, 0, 0); __builtin_amdgcn_s_setprio(0); } while (0)
#define PG8_LDA8(dst, b, h) do { _Pragma("unroll") for (int m = 0; m < 4; ++m) { const v4i lo_ = *(const PG8_LAS v4i*)(lds + PG8_SA(b, h) + aoff + m * 2048), hi_ = *(const PG8_LAS v4i*)(lds + PG8_SA(b, h) + aoff + m * 2048 + 1024); \
        dst[m] = __builtin_shufflevector(lo_, hi_, 0, 1, 2, 3, 4, 5, 6, 7); } } while (0)
#define PG8_LDB8(dst, b, h) do { _Pragma("unroll") for (int n = 0; n < 2; ++n) { const v4i lo_ = *(const PG8_LAS v4i*)(lds + PG8_SB(b, h) + boff + n * 2048), hi_ = *(const PG8_LAS v4i*)(lds + PG8_SB(b, h) + boff + n * 2048 + 1024); \
        dst[n] = __builtin_shufflevector(lo_, hi_, 0, 1, 2, 3, 4, 5, 6, 7); } } while (0)
#define PG8_MMA8(ai, bj, A8_, B8_) do { __builtin_amdgcn_s_setprio(1); _Pragma("unroll") for (int m = 0; m < 4; ++m) _Pragma("unroll") for (int n = 0; n < 2; ++n) \
        acc[ai][bj][m][n] = __builtin_amdgcn_mfma_scale_f32_16x16x128_f8f6f4(B8_[n], A8_[m], acc[ai][bj][m][n], 0, 0, 0, 0, 0, 0);     __builtin_amdgcn_s_setprio(0); } while (0)
#define PG8_XLDA(b, h) do { if constexpr (Epi::FP8) PG8_LDA8(A8, b, h); else PG8_LDA(At, b, h); } while (0)
#define PG8_XLDB0(b, h) do { if constexpr (Epi::FP8) PG8_LDB8(B08, b, h); else PG8_LDB(B0, b, h); } while (0)
#define PG8_XLDB1(b, h) do { if constexpr (Epi::FP8) PG8_LDB8(B18, b, h); else PG8_LDB(B1, b, h); } while (0)
#define PG8_XMM0(ai, bj) do { if constexpr (Epi::FP8) PG8_MMA8(ai, bj, A8, B08); else PG8_MMA(ai, bj, At, B0); } while (0)
#define PG8_XMM1(ai, bj) do { if constexpr (Epi::FP8) PG8_MMA8(ai, bj, A8, B18); else PG8_MMA(ai, bj, At, B1); } while (0)
#define PG8_WAIT_V(n) asm volatile("s_waitcnt vmcnt(" #n ")" ::: "memory")
#define PG8_WAIT_L(n) asm volatile("s_waitcnt lgkmcnt(" #n ")" ::: "memory")
#define PG8_BAR __builtin_amdgcn_s_barrier()
#define PG8_SCHED __builtin_amdgcn_sched_barrier(0)
    Unit cur, nxt; int ui = 0;
    if (!S.next(0, cur)) return;
    f32x4 acc[2][2][4][2];
#pragma unroll
    for (int a = 0; a < 2; ++a)
#pragma unroll
        for (int b = 0; b < 2; ++b)
#pragma unroll
            for (int m = 0; m < 4; ++m)
#pragma unroll
                for (int n = 0; n < 2; ++n) acc[a][b][m][n] = (f32x4){0.f, 0.f, 0.f, 0.f};
    bf16x8 At[4][2], B0[2][2], B1[2][2];
    v8i A8[4], B08[2], B18[2];
    unsigned cBo = S.boff(cur);
    PG8_STAGE_B(PG8_SB(0, 0), cBo); PG8_STAGE_B(PG8_SB(0, 1), cBo + hstep); PG8_STAGE_A(PG8_SA(0, 0), cur, 0, 0u); PG8_STAGE_A(PG8_SA(0, 1), cur, 1, 0u);
    if (wr == 1) PG8_BAR;
    PG8_WAIT_V(2); PG8_BAR;
    PG8_STAGE_B(PG8_SB(1, 0), cBo + 128u); PG8_STAGE_A(PG8_SA(1, 0), cur, 0, 128u); PG8_STAGE_B(PG8_SB(1, 1), cBo + hstep + 128u);
    PG8_WAIT_V(6); PG8_BAR;
    for (;;) {
        if constexpr (Epi::BIAS) E.prefetch(cur, ui, wid);
        const bool has_next = S.next(ui + 1, nxt);
        const unsigned nBo = has_next ? S.boff(nxt) : cBo;
        for (int th = 0; th < (Epi::HAS_MID ? 2 : 1); ++th) {
        if constexpr (Epi::HAS_MID) { if (th == 1) E.mid(acc, ui, wr, lane_id() & 15); }
        const int tbeg = Epi::HAS_MID ? th * (nt / 2) : 0, tend = Epi::HAS_MID ? (th + 1) * (nt / 2) : nt;
#pragma unroll 1
        for (int t = tbeg; t < tend; t += 2) {
            const bool last = (t == nt - 2);
            const unsigned k1 = (unsigned)(t + 1) * 128u;
            const unsigned k2 = last ? 0u : (unsigned)(t + 2) * 128u;
            const unsigned k3 = k2 + 128u;
            const unsigned b2 = (last ? nBo : cBo) + k2, b3 = b2 + 128u;
            Unit u2 = cur; if (last && has_next) u2 = nxt;
            PG8_XLDB0(0, 0); PG8_XLDB1(0, 1); PG8_SCHED; PG8_XLDA(0, 0); PG8_STAGE_A(PG8_SA(1, 1), cur, 1, k1);
            PG8_WAIT_V(8); PG8_WAIT_L(0); PG8_BAR; PG8_XMM0(0, 0); PG8_XMM1(0, 1); PG8_BAR; PG8_SCHED;
            PG8_XLDA(0, 1); PG8_STAGE_B(PG8_SB(0, 0), b2); PG8_STAGE_B(PG8_SB(0, 1), b2 + hstep); PG8_STAGE_A(PG8_SA(0, 0), u2, 0, k2);
            PG8_WAIT_V(8); PG8_WAIT_L(0); PG8_BAR; PG8_XMM0(1, 0); PG8_XMM1(1, 1); PG8_BAR; PG8_SCHED;
            PG8_XLDB0(1, 0); PG8_XLDB1(1, 1); PG8_SCHED; PG8_XLDA(1, 0); PG8_STAGE_A(PG8_SA(0, 1), u2, 1, k2);
            PG8_WAIT_V(8); PG8_WAIT_L(0); PG8_BAR; PG8_XMM0(0, 0); PG8_XMM1(0, 1); PG8_BAR; PG8_SCHED;
            PG8_XLDA(1, 1); PG8_STAGE_B(PG8_SB(1, 0), b3); PG8_STAGE_B(PG8_SB(1, 1), b3 + hstep); PG8_STAGE_A(PG8_SA(1, 0), u2, 0, k3);
            PG8_WAIT_V(8); PG8_WAIT_L(0); PG8_BAR; PG8_XMM0(1, 0); PG8_XMM1(1, 1); PG8_BAR; PG8_SCHED;
        }
        }
        if constexpr (ALIGN_EPI) { if (wr == 0) PG8_BAR; }
        { const int l2 = lane_id(); E(acc, cur, ui, wr, wc, l2 & 15, l2 >> 4); }
        if (!has_next) break;
#pragma unroll
        for (int a = 0; a < 2; ++a)
#pragma unroll
            for (int b = 0; b < 2; ++b)
#pragma unroll
                for (int m = 0; m < 4; ++m)
#pragma unroll
                    for (int n = 0; n < 2; ++n) acc[a][b][m][n] = (f32x4){0.f, 0.f, 0.f, 0.f};
        cur = nxt; cBo = nBo; ++ui;
        if constexpr (ALIGN_EPI) { if (wr == 1) PG8_BAR; }
    }
    PG8_WAIT_V(0);
    if constexpr (!ALIGN_EPI) { if (wr == 0) PG8_BAR; }
    PG8_BAR;
#undef PG8_SA
#undef PG8_SB
#undef PG8_STAGE_A
#undef PG8_STAGE_B
#undef PG8_LDA
#undef PG8_LDB
#undef PG8_MMA
#undef PG8_MMA8
#undef PG8_LDA8
#undef PG8_LDB8
#undef PG8_XLDA
#undef PG8_XLDB0
#undef PG8_XLDB1
#undef PG8_XMM0
#undef PG8_XMM1
#undef PG8_WAIT_V
#undef PG8_WAIT_L
#undef PG8_BAR
#undef PG8_SCHED
}

struct StaticOrder {
    int nM, nN, nwg, G, c; const char* Bt; int K;
    __device__ void init(int M, int N, int G_, int c_, const void* Bt_, int K_) { nM = M / BM; nN = N / BM; nwg = nM * nN; G = G_; c = c_; Bt = (const char*)Bt_; K = K_; }
    __device__ __forceinline__ bool next(int i, Unit& u) const {
        const long L = (long)i * G + c; if (L >= nwg) return false;
        int wgid = (int)L; { const int q = nwg / NXCD, r = nwg % NXCD, xcd = wgid % NXCD, off = wgid / NXCD; wgid = (xcd < r ? xcd * (q + 1) : r * (q + 1) + (xcd - r) * q) + off; }
        const int nig = WGM * nN, gid = wgid / nig, fm = gid * WGM, gsz = (nM - fm) < WGM ? (nM - fm) : WGM;
        u.pm = fm + ((wgid % nig) % gsz); u.pn = (wgid % nig) / gsz; u.e = 0; u.nrows = 256; u.slot = i; return true;
    }
    __device__ __forceinline__ unsigned boff(const Unit& u) const { return (unsigned)u.pn * (unsigned)(BM * K * 2); }
    __device__ __forceinline__ unsigned arow_off(const Unit& u, int r) const { return (unsigned)(u.pm * BM + r) * (unsigned)(K * 2); }
};

struct EpiProj {
    static constexpr bool PERM = true, HAS_MID = false, FP8 = false, BIAS = false;
    bf16* O;
    __device__ __forceinline__ void operator()(const f32x4 (&acc)[2][2][4][2], const Unit& u, int ui, int wr, int wc, int fr, int fq) const {
        const int row0 = u.pm * BM + wr * 64 + fr; const int colt = u.pn * BM; const int t = colt / 512;
        bf16* base = O + (size_t)t * PROJ_STRIDE; const float sc = (t == 0) ? C2 : 1.f;
        const int col0 = (colt - t * 512) + wc * 32 + 8 * fq;
#pragma unroll
        for (int ai = 0; ai < 2; ++ai)
#pragma unroll
            for (int m = 0; m < 4; ++m) { bf16* rowp = base + (size_t)(row0 + ai * HALF + m * 16) * 512 + col0;
#pragma unroll
                for (int bj = 0; bj < 2; ++bj) { const f32x4 v0 = acc[ai][bj][m][0] * sc, v1 = acc[ai][bj][m][1] * sc;
                    u32x4 w; w.x = cvt_pk_bf16(v0[0], v0[1]); w.y = cvt_pk_bf16(v0[2], v0[3]); w.z = cvt_pk_bf16(v1[0], v1[1]); w.w = cvt_pk_bf16(v1[2], v1[3]);
                    *(u32x4*)(rowp + bj * HALF) = w; } }
    }
};

constexpr int MAXTILES = 544;
struct MoeTables { PG8_LAS int* te; PG8_LAS int* toff; PG8_LAS int* tn; PG8_LAS int* ent; PG8_LAS float* pw; int ntiles; };
__device__ __forceinline__ MoeTables moe_tables(PG8_LAS unsigned char* tab, const unsigned* cnt, int tid) {
    PG8_LAS int* tc = (PG8_LAS int*)tab;
    MoeTables T; T.te = tc + 64; T.toff = T.te + MAXTILES; T.tn = T.toff + MAXTILES; T.ent = T.tn + MAXTILES; T.pw = (PG8_LAS float*)(T.ent + 9 * 256);
    if (tid < 32) tc[tid] = (int)cnt[tid];
    __syncthreads();
    for (int t = tid; t < MAXTILES; t += 512) {
        int e = 0, accu = 0;
        for (; e < 32; ++e) { const int nt_e = (tc[e] + 255) >> 8; if (t < accu + nt_e) break; accu += nt_e; }
        if (e < 32) { const int off = (t - accu) * 256; T.te[t] = e; T.toff[t] = off; const int rem = tc[e] - off; T.tn[t] = rem < 256 ? rem : 256; }
    }
    if (tid == 0) { int s = 0; for (int e = 0; e < 32; ++e) s += (tc[e] + 255) >> 8; tc[32] = s; }
    __syncthreads();
    T.ntiles = __builtin_amdgcn_readfirstlane(tc[32]);
    return T;
}
struct MoeOrder {
    const char* Bt; int ncol, shift; MoeTables T; int xcd, iin, gx; int seq;
    __device__ __forceinline__ bool next(int i, Unit& u) const {
        int t, pn;
        if (seq) {
            const int nblk = gx * NXCD, nfull = T.ntiles / nblk, rem = T.ntiles - nfull * nblk;
            if (i < nfull * ncol) { t = (i / ncol) * nblk + xcd * gx + iin; pn = i % ncol; }
            else { const int r = (i - nfull * ncol) * nblk + iin * NXCD + xcd; if (r >= rem * ncol) return false; t = nfull * nblk + r / ncol; pn = r % ncol; }
        } else {
            const int rpx = gx / ncol, rl = iin / ncol; if (rl >= rpx) return false;
            t = (i * NXCD + xcd) * rpx + rl; if (t >= T.ntiles) return false; pn = iin % ncol;
        }
        u.e = __builtin_amdgcn_readfirstlane(T.te[t]); u.pm = __builtin_amdgcn_readfirstlane(T.toff[t]); u.nrows = __builtin_amdgcn_readfirstlane(T.tn[t]); u.pn = pn; u.slot = i; return true;
    }
    __device__ __forceinline__ void load_entries(const int* list, const float* pasg, int tid) const {
        const int w = tid >> 6, l = tid & 63; Unit u[3]; bool ok[3]; int en[3][4]; float pv[3][4];
#pragma unroll
        for (int j = 0; j < 3; ++j) { ok[j] = next(w + 8 * j, u[j]);
#pragma unroll
            for (int q = 0; q < 4; ++q) { const int r = 64 * q + l; en[j][q] = ok[j] ? list[u[j].e * NTOK + u[j].pm + (r < u[j].nrows ? r : 0)] : 0; } }
#pragma unroll
        for (int j = 0; j < 3; ++j)
#pragma unroll
            for (int q = 0; q < 4; ++q) pv[j][q] = (pasg && ok[j]) ? pasg[en[j][q]] : 0.f;
#pragma unroll
        for (int j = 0; j < 3; ++j) if (ok[j]) {
#pragma unroll
            for (int q = 0; q < 4; ++q) { T.ent[(w + 8 * j) * 256 + 64 * q + l] = en[j][q]; if (pasg) T.pw[(w + 8 * j) * 256 + 64 * q + l] = pv[j][q]; } }
        __syncthreads();
    }
    __device__ __forceinline__ unsigned boff(const Unit& u) const { return (unsigned)(u.e * ncol + u.pn) * (unsigned)(BM * 1024); }
    __device__ __forceinline__ unsigned arow_off(const Unit& u, int r) const { return (unsigned)(T.ent[u.slot * 256 + r] >> shift) * 1024u; }
};
struct EpiGU {
    static constexpr bool PERM = true, HAS_MID = false, FP8 = true, BIAS = true;
    PG8_LAS const int* ent; const float* bg; const float* bu; unsigned char* act; PG8_LAS const float* bl;
    __device__ __forceinline__ void prefetch(const Unit& u, int ui, int wid) const {
        if (wid == 0) { const int l = lane_id(); glds16((l < 32 ? bg : bu) + u.e * DE + u.pn * 128 + (l & 31) * 4, lds_addr(bl + (ui & 1) * 256)); }
    }
    __device__ __forceinline__ void operator()(const f32x4 (&acc)[2][2][4][2], const Unit& u, int ui, int wr, int wc, int fr, int fq) const {
        const int cb = u.pn * 128 + wc * 32 + 8 * fq;
        PG8_LAS const float* bp = bl + (ui & 1) * 256 + wc * 32 + 8 * fq;
        const f32x4 g0 = *(PG8_LAS const f32x4*)bp, g1 = *(PG8_LAS const f32x4*)(bp + 4), u0 = *(PG8_LAS const f32x4*)(bp + 128), u1 = *(PG8_LAS const f32x4*)(bp + 132);
        PG8_LAS const int* lp = ent + u.slot * 256;
        int en8[2][4];
#pragma unroll
        for (int ai = 0; ai < 2; ++ai)
#pragma unroll
            for (int m = 0; m < 4; ++m) en8[ai][m] = lp[ai * HALF + wr * 64 + m * 16 + fr];
        asm volatile("" : "+v"(en8[0][0]), "+v"(en8[0][1]), "+v"(en8[0][2]), "+v"(en8[0][3]), "+v"(en8[1][0]), "+v"(en8[1][1]), "+v"(en8[1][2]), "+v"(en8[1][3]));
#pragma unroll
        for (int ai = 0; ai < 2; ++ai)
#pragma unroll
            for (int m = 0; m < 4; ++m) { const int r = ai * HALF + wr * 64 + m * 16 + fr; const int entry = en8[ai][m];
                f32x4 gv[2] = {acc[ai][0][m][0] + g0, acc[ai][0][m][1] + g1}, uv[2] = {acc[ai][1][m][0] + u0, acc[ai][1][m][1] + u1}; float o[8];
#pragma unroll
                for (int n = 0; n < 2; ++n)
#pragma unroll
                    for (int i = 0; i < 4; ++i) { const float g = fminf(gv[n][i], 7.f), uu = fminf(fmaxf(uv[n][i], -7.f), 7.f);
                        o[4 * n + i] = (uu + 1.f) * g * __builtin_amdgcn_rcpf(1.f + __builtin_amdgcn_exp2f(-1.702f * 1.4426950408889634f * g)); }
                typedef unsigned u32x2 __attribute__((ext_vector_type(2)));
                const u32x2 w = {pk4_fp8_raw(o[0], o[1], o[2], o[3]), pk4_fp8_raw(o[4], o[5], o[6], o[7])};
                if (r < u.nrows) *(u32x2*)(act + (size_t)entry * DE + cb) = w; }
    }
};
struct EpiDown {
    static constexpr bool PERM = true, HAS_MID = false, FP8 = true, BIAS = true;
    PG8_LAS const int* ent; const float* bd; PG8_LAS const float* pw; unsigned char* yb; PG8_LAS const float* bl;
    __device__ __forceinline__ void prefetch(const Unit& u, int ui, int wid) const {
        if (wid == 0) { const int l = lane_id(); glds16(bd + u.e * DM + u.pn * BM + l * 4, lds_addr(bl + (ui & 1) * 256)); }
    }
    __device__ __forceinline__ void operator()(const f32x4 (&acc)[2][2][4][2], const Unit& u, int ui, int wr, int wc, int fr, int fq) const {
        const int cb = u.pn * BM + wc * 32 + 8 * fq;
        f32x4 bv[2][2];
#pragma unroll
        for (int bj = 0; bj < 2; ++bj)
#pragma unroll
            for (int n = 0; n < 2; ++n) bv[bj][n] = *(PG8_LAS const f32x4*)(bl + (ui & 1) * 256 + bj * HALF + wc * 32 + 8 * fq + 4 * n);
        PG8_LAS const int* lp = ent + u.slot * 256;
        int en8[2][4]; float p8[2][4];
#pragma unroll
        for (int ai = 0; ai < 2; ++ai)
#pragma unroll
            for (int m = 0; m < 4; ++m) { en8[ai][m] = lp[ai * HALF + wr * 64 + m * 16 + fr]; p8[ai][m] = pw[u.slot * 256 + ai * HALF + wr * 64 + m * 16 + fr]; }
        asm volatile("" : "+v"(en8[0][0]), "+v"(en8[0][1]), "+v"(en8[0][2]), "+v"(en8[0][3]), "+v"(en8[1][0]), "+v"(en8[1][1]), "+v"(en8[1][2]), "+v"(en8[1][3]));
        asm volatile("" : "+v"(p8[0][0]), "+v"(p8[0][1]), "+v"(p8[0][2]), "+v"(p8[0][3]), "+v"(p8[1][0]), "+v"(p8[1][1]), "+v"(p8[1][2]), "+v"(p8[1][3]));
#pragma unroll
        for (int ai = 0; ai < 2; ++ai)
#pragma unroll
            for (int m = 0; m < 4; ++m) { const int r = ai * HALF + wr * 64 + m * 16 + fr; const int entry = en8[ai][m]; const float p = p8[ai][m];
                unsigned char* rowp = yb + (size_t)entry * DM + cb;
#pragma unroll
                for (int bj = 0; bj < 2; ++bj) { const f32x4 v0 = (acc[ai][bj][m][0] + bv[bj][0]) * p, v1 = (acc[ai][bj][m][1] + bv[bj][1]) * p;
                    typedef unsigned u32x2 __attribute__((ext_vector_type(2)));
                    if (r < u.nrows) *(u32x2*)(rowp + bj * HALF) = (u32x2){pk4_fp8_m3(v0[0], v0[1], v0[2], v0[3]), pk4_fp8_m3(v1[0], v1[1], v1[2], v1[3])}; } }
    }
};
struct EpiOut {
    static constexpr bool PERM = true, HAS_MID = true, FP8 = false, BIAS = false;
    const float* x; const float* mod; bf16* x1b; float* ssx; PG8_LAS const float* rst;
    __device__ __forceinline__ void mid(f32x4 (&acc)[2][2][4][2], int ui, int wr, int fr) const {
#pragma unroll
        for (int ai = 0; ai < 2; ++ai)
#pragma unroll
            for (int m = 0; m < 4; ++m) { const int r = ai * HALF + wr * 64 + m * 16 + fr; const float ra = rst[(ui * 256 + r) * 2], rl = rst[(ui * 256 + r) * 2 + 1]; const float ratio = ra / rl;
#pragma unroll
                for (int bj = 0; bj < 2; ++bj)
#pragma unroll
                    for (int n = 0; n < 2; ++n) acc[ai][bj][m][n] = acc[ai][bj][m][n] * ratio; }
    }
    __device__ __forceinline__ void operator()(const f32x4 (&acc)[2][2][4][2], const Unit& u, int ui, int wr, int wc, int fr, int fq) const {
        const int b = (u.pm * BM) / SEQ; const float* gm = mod + b * 6144 + 2048;
        const int cb = u.pn * BM + wc * 32 + 8 * fq;
        f32x4 gv[2][2];
#pragma unroll
        for (int bj = 0; bj < 2; ++bj)
#pragma unroll
            for (int n = 0; n < 2; ++n) gv[bj][n] = *(const f32x4*)(gm + cb + bj * HALF + 4 * n);
#pragma unroll
        for (int ai = 0; ai < 2; ++ai)
#pragma unroll
            for (int m = 0; m < 4; ++m) { const int r = ai * HALF + wr * 64 + m * 16 + fr; const size_t grow = (size_t)u.pm * BM + r; const float rl = rst[(ui * 256 + r) * 2 + 1];
                float ss = 0.f;
#pragma unroll
                for (int bj = 0; bj < 2; ++bj) { const float* xp = x + grow * DM + cb + bj * HALF;
                    const f32x4 v0 = *(const f32x4*)xp + gv[bj][0] * (acc[ai][bj][m][0] * rl), v1 = *(const f32x4*)(xp + 4) + gv[bj][1] * (acc[ai][bj][m][1] * rl);
                    ss += (v0[0] * v0[0] + v0[1] * v0[1]) + (v0[2] * v0[2] + v0[3] * v0[3]) + (v1[0] * v1[0] + v1[1] * v1[1]) + (v1[2] * v1[2] + v1[3] * v1[3]);
                    u32x4 w; w.x = cvt_pk_bf16(v0[0], v0[1]); w.y = cvt_pk_bf16(v0[2], v0[3]); w.z = cvt_pk_bf16(v1[0], v1[1]); w.w = cvt_pk_bf16(v1[2], v1[3]);
                    *(u32x4*)(x1b + grow * DM + cb + bj * HALF) = w; }
                ss += __shfl_xor(ss, 16); ss += __shfl_xor(ss, 32);
                if (fq == 0) ssx[grow * 16 + u.pn * 4 + wc] = ss;
                asm volatile("" ::: "memory"); }
    }
};
}


__device__ __forceinline__ void p5_router(const Args& a, LAS unsigned char* lds, int tid, int lane, int wave, int G) {
    typedef short bf16x8 __attribute__((ext_vector_type(8)));
    LAS float* ab = (LAS float*)(lds + TAB_OFF);
    LAS float* lg = ab + 2048 + wave * 512;
    LAS unsigned* hist = (LAS unsigned*)(lds + TAB_OFF + 8192 + 16384);
    const int col = lane & 15, kq = lane >> 4;
    const bf16* x1b = (const bf16*)(a.wsp() + WS_X1B);
    u32x4 xv[32];
#define P5_LOADX(bt) do { const u32x4* xr_ = (const u32x4*)(x1b + (size_t)((bt) * 128 + wave * 16 + col) * DM) + kq; _Pragma("unroll") for (int i_ = 0; i_ < 32; ++i_) xv[i_] = xr_[4 * i_]; } while (0)
    if ((int)blockIdx.x < NTOK / 128) P5_LOADX((int)blockIdx.x);
    { const u32x4* wsrc = (const u32x4*)(a.wsp() + WS_WR);
      for (int i = tid; i < 2 * 32 * 128; i += 512) { const int hl = i >> 12, e = (i >> 7) & 31, c = i & 127;
          *(LAS u32x4*)(lds + hl * 65536 + e * 2048 + ((c ^ (e & 15)) << 4)) = wsrc[i]; } }
    const float* mod = (const float*)(a.wsp() + WS_MOD); const float* ssx = (const float*)(a.wsp() + WS_SSX);
    unsigned char* h2 = (unsigned char*)a.outp() + DO_H2;
    unsigned* cnt = (unsigned*)(a.wsp() + WS_CTL) + CW_CNT; int* list = (int*)(a.wsp() + WS_LIST); float* pasg = (float*)(a.wsp() + WS_PASG);
    int cur_b = -1;
    for (int batch = blockIdx.x; batch < NTOK / 128; batch += G) {
        const int b = (batch * 128) / SEQ;
        __syncthreads();
        if (b != cur_b) { for (int k = tid; k < 1024; k += 512) { ab[k] = a.inp(I_FFNG)[k] * (1.f + mod[b * 6144 + 4096 + k]); ab[1024 + k] = mod[b * 6144 + 3072 + k]; } cur_b = b; }
        if (tid < 64) hist[tid] = 0u;
        __syncthreads();
        const int tok = batch * 128 + wave * 16 + col;
        float rs2;
        { const f32x4 pp = *(const f32x4*)(ssx + (size_t)tok * 16 + 4 * kq); float s = (pp.x + pp.y) + (pp.z + pp.w); s += __shfl_xor(s, 16); s += __shfl_xor(s, 32); rs2 = rsqrtf(s * (1.f / 1024.f) + EPS); }
        typedef unsigned u32x2 __attribute__((ext_vector_type(2))); u32x2* hrow = (u32x2*)(h2 + (size_t)tok * DM) + kq;
        f32x4 acc0 = {0.f, 0.f, 0.f, 0.f}, acc1 = {0.f, 0.f, 0.f, 0.f};
        const LAS unsigned char* wb = lds + col * 2048;
#pragma unroll
        for (int kb = 0; kb < 32; kb += 8) {
#pragma unroll
            for (int i = 0; i < 8; ++i) { const int ks = kb + i;
                float xf[8]; unpack8(xv[ks], xf);
                const LAS f32x4* al = (const LAS f32x4*)(ab + 32 * ks + 8 * kq); const LAS f32x4* be = (const LAS f32x4*)(ab + 1024 + 32 * ks + 8 * kq);
                const f32x4 a0 = al[0], a1 = al[1], b0 = be[0], b1 = be[1];
                float h[8] = {xf[0] * rs2 * a0.x + b0.x, xf[1] * rs2 * a0.y + b0.y, xf[2] * rs2 * a0.z + b0.z, xf[3] * rs2 * a0.w + b0.w,
                              xf[4] * rs2 * a1.x + b1.x, xf[5] * rs2 * a1.y + b1.y, xf[6] * rs2 * a1.z + b1.z, xf[7] * rs2 * a1.w + b1.w};
                u32x4 hh, hl;
                hh.x = pg8::cvt_pk_bf16(h[0], h[1]); hh.y = pg8::cvt_pk_bf16(h[2], h[3]); hh.z = pg8::cvt_pk_bf16(h[4], h[5]); hh.w = pg8::cvt_pk_bf16(h[6], h[7]);
                float hf[8]; unpack8(hh, hf);
                hl.x = pg8::cvt_pk_bf16(h[0] - hf[0], h[1] - hf[1]); hl.y = pg8::cvt_pk_bf16(h[2] - hf[2], h[3] - hf[3]); hl.z = pg8::cvt_pk_bf16(h[4] - hf[4], h[5] - hf[5]); hl.w = pg8::cvt_pk_bf16(h[6] - hf[6], h[7] - hf[7]);
                hrow[4 * ks] = (u32x2){pk4_fp8_m3(h[0], h[1], h[2], h[3]), pk4_fp8_m3(h[4], h[5], h[6], h[7])};
                const int so = ((4 * ks + kq) ^ col) << 4;
                const bf16x8 bh0 = *(const LAS bf16x8*)(wb + so), bh1 = *(const LAS bf16x8*)(wb + 32768 + so), bl0 = *(const LAS bf16x8*)(wb + 65536 + so), bl1 = *(const LAS bf16x8*)(wb + 65536 + 32768 + so);
                const bf16x8 ah = __builtin_bit_cast(bf16x8, hh), alo = __builtin_bit_cast(bf16x8, hl);
                acc0 = __builtin_amdgcn_mfma_f32_16x16x32_bf16(ah, bh0, acc0, 0, 0, 0); acc1 = __builtin_amdgcn_mfma_f32_16x16x32_bf16(ah, bh1, acc1, 0, 0, 0);
                acc0 = __builtin_amdgcn_mfma_f32_16x16x32_bf16(ah, bl0, acc0, 0, 0, 0); acc1 = __builtin_amdgcn_mfma_f32_16x16x32_bf16(ah, bl1, acc1, 0, 0, 0);
                acc0 = __builtin_amdgcn_mfma_f32_16x16x32_bf16(alo, bh0, acc0, 0, 0, 0); acc1 = __builtin_amdgcn_mfma_f32_16x16x32_bf16(alo, bh1, acc1, 0, 0, 0);
            }
        }
        if (batch + G < NTOK / 128) P5_LOADX(batch + G);
        { const float rb0 = a.inp(I_RB)[col], rb1 = a.inp(I_RB)[16 + col];
#pragma unroll
          for (int r = 0; r < 4; ++r) { lg[(4 * kq + r) * 32 + col] = acc0[r] + rb0; lg[(4 * kq + r) * 32 + 16 + col] = acc1[r] + rb1; } }
        LDS_WAIT();
        int e0 = 0, e1 = 0, e2 = 0, e3 = 0; unsigned r0 = 0, r1 = 0, r2 = 0, r3 = 0; float p0 = 0.f, p1 = 0.f, p2 = 0.f, p3 = 0.f;
        if (lane < 16) {
            float v[32];
#pragma unroll
            for (int q = 0; q < 8; ++q) { const f32x4 t = *(const LAS f32x4*)(lg + lane * 32 + 4 * q); v[4 * q] = t.x; v[4 * q + 1] = t.y; v[4 * q + 2] = t.z; v[4 * q + 3] = t.w; }
            unsigned chosen = 0u; float tv[4]; int ti[4];
#pragma unroll
            for (int k = 0; k < 4; ++k) { float bv = -INFINITY; int bi = 0;
#pragma unroll
                for (int e = 0; e < 32; ++e) { const float c = ((chosen >> e) & 1u) ? -INFINITY : v[e]; if (c > bv) { bv = c; bi = e; } }
                tv[k] = bv; ti[k] = bi; chosen |= 1u << bi; }
            const float q1 = __expf(tv[1] - tv[0]), q2 = __expf(tv[2] - tv[0]), q3 = __expf(tv[3] - tv[0]), inv = 1.f / (1.f + q1 + q2 + q3);
            e0 = ti[0]; e1 = ti[1]; e2 = ti[2]; e3 = ti[3]; p0 = inv; p1 = q1 * inv; p2 = q2 * inv; p3 = q3 * inv;
            r0 = __hip_atomic_fetch_add(hist + e0, 1u, __ATOMIC_RELAXED, __HIP_MEMORY_SCOPE_WORKGROUP); r1 = __hip_atomic_fetch_add(hist + e1, 1u, __ATOMIC_RELAXED, __HIP_MEMORY_SCOPE_WORKGROUP);
            r2 = __hip_atomic_fetch_add(hist + e2, 1u, __ATOMIC_RELAXED, __HIP_MEMORY_SCOPE_WORKGROUP); r3 = __hip_atomic_fetch_add(hist + e3, 1u, __ATOMIC_RELAXED, __HIP_MEMORY_SCOPE_WORKGROUP);
        }
        __syncthreads();
        if (tid < 32) hist[32 + tid] = atomicAdd(&cnt[tid], hist[tid]);
        __syncthreads();
        if (lane < 16) { const int tk = batch * 128 + wave * 16 + lane;
            list[e0 * NTOK + hist[32 + e0] + r0] = tk * 4 + 0; list[e1 * NTOK + hist[32 + e1] + r1] = tk * 4 + 1; list[e2 * NTOK + hist[32 + e2] + r2] = tk * 4 + 2; list[e3 * NTOK + hist[32 + e3] + r3] = tk * 4 + 3;
            *(f32x4*)(pasg + (size_t)tk * 4) = (f32x4){p0, p1, p2, p3}; }
    }
}


namespace att {
typedef short bf16x8 __attribute__((ext_vector_type(8)));
typedef short s16x4 __attribute__((ext_vector_type(4)));
typedef float f32x16 __attribute__((ext_vector_type(16)));
constexpr int NTW = 7;
constexpr int LDS_K = 0, LDS_V = NTW * 8192, LDS_FLAG = 2 * NTW * 8192;
constexpr float ATT_THR = 32.f;
__device__ __forceinline__ int crow(int r, int hh) { return (r & 3) + 8 * (r >> 2) + 4 * hh; }
__device__ __forceinline__ bf16x8 pack8(const float* v) {
    u32x4 w; w.x = pg8::cvt_pk_bf16(v[0], v[1]); w.y = pg8::cvt_pk_bf16(v[2], v[3]); w.z = pg8::cvt_pk_bf16(v[4], v[5]); w.w = pg8::cvt_pk_bf16(v[6], v[7]); return __builtin_bit_cast(bf16x8, w);
}
__device__ __forceinline__ s16x4 vtr(const LAS unsigned char* p) { typedef short v4i16_t __attribute__((ext_vector_type(4))); return __builtin_bit_cast(s16x4, __builtin_amdgcn_ds_read_tr16_b64_v4i16((LAS v4i16_t*)p)); }
template <bool DIAG>
__device__ __forceinline__ void block32(f32x16& o0, f32x16& o1, float& c, const bf16x8 (&qf)[4], const bf16x8 (&Mf)[2], const LAS unsigned char* Kb, const LAS unsigned char* Vb, int kbl, int r32, int hh, int lane) {
    f32x16 st = {0.f, 0.f, 0.f, 0.f, 0.f, 0.f, 0.f, 0.f, 0.f, 0.f, 0.f, 0.f, 0.f, 0.f, 0.f, 0.f};
#pragma unroll
    for (int ks = 0; ks < 4; ++ks) { const bf16x8 kf = *(const LAS bf16x8*)(Kb + (2 * ks + hh) * 1024 + (32 * kbl + r32) * 16); st = __builtin_amdgcn_mfma_f32_32x32x16_bf16(kf, qf[ks], st, 0, 0, 0); }
    float u[16], L[16];
#pragma unroll
    for (int r = 0; r < 16; ++r) { float uu = __builtin_amdgcn_exp2f(fminf(st[r], 115.f)); if (DIAG) { if (crow(r, hh) >= r32) uu = 0.f; } u[r] = uu; L[r] = __builtin_amdgcn_logf(1.f + uu); }
    const bf16x8 lp0 = pack8(L), lp1 = pack8(L + 8);
    f32x16 inc = {0.f, 0.f, 0.f, 0.f, 0.f, 0.f, 0.f, 0.f, 0.f, 0.f, 0.f, 0.f, 0.f, 0.f, 0.f, 0.f};
    inc = __builtin_amdgcn_mfma_f32_32x32x16_bf16(Mf[0], lp0, inc, 0, 0, 0); inc = __builtin_amdgcn_mfma_f32_32x32x16_bf16(Mf[1], lp1, inc, 0, 0, 0);
    float tot; { const unsigned t0 = __float_as_uint(inc[0]); auto rr = __builtin_amdgcn_permlane32_swap(t0, t0, false, false); tot = __uint_as_float(rr[0]); }
    float w[16];
#pragma unroll
    for (int r = 0; r < 16; ++r) w[r] = u[r] * __builtin_amdgcn_exp2f(inc[r] + c);
    c += tot;
    const bf16x8 pw0 = pack8(w), pw1 = pack8(w + 8);
    const LAS unsigned char* vp = Vb + ((lane >> 4) & 1) * 32 + (lane & 3) * 8 + (4 * hh + ((lane & 15) >> 2)) * 64 + (2 * kbl) * 1024;
#pragma unroll
    for (int db = 0; db < 2; ++db) {
        const s16x4 l0 = vtr(vp + db * 4096), h0 = vtr(vp + db * 4096 + 512), l1 = vtr(vp + db * 4096 + 1024), h1 = vtr(vp + db * 4096 + 1024 + 512);
        const bf16x8 v0 = (bf16x8){l0[0], l0[1], l0[2], l0[3], h0[0], h0[1], h0[2], h0[3]}, v1 = (bf16x8){l1[0], l1[1], l1[2], l1[3], h1[0], h1[1], h1[2], h1[3]};
        if (db == 0) { o0 = __builtin_amdgcn_mfma_f32_32x32x16_bf16(v0, pw0, o0, 0, 0, 0); o0 = __builtin_amdgcn_mfma_f32_32x32x16_bf16(v1, pw1, o0, 0, 0, 0); }
        else         { o1 = __builtin_amdgcn_mfma_f32_32x32x16_bf16(v0, pw0, o1, 0, 0, 0); o1 = __builtin_amdgcn_mfma_f32_32x32x16_bf16(v1, pw1, o1, 0, 0, 0); }
    }
}
__device__ __forceinline__ void tile64(f32x16& o0, f32x16& o1, float& c, const bf16x8 (&qf)[4], const bf16x8 (&Mf)[2], const LAS unsigned char* Kb, const LAS unsigned char* Vb, int r32, int hh, int lane) {
    const f32x16 z16 = {0.f, 0.f, 0.f, 0.f, 0.f, 0.f, 0.f, 0.f, 0.f, 0.f, 0.f, 0.f, 0.f, 0.f, 0.f, 0.f};
    bf16x8 kf[8];
#pragma unroll
    for (int q = 0; q < 8; ++q) kf[q] = *(const LAS bf16x8*)(Kb + (2 * (q & 3) + hh) * 1024 + (32 * (q >> 2) + r32) * 16);
    asm volatile("" : "+v"(kf[0]), "+v"(kf[1]), "+v"(kf[2]), "+v"(kf[3]), "+v"(kf[4]), "+v"(kf[5]), "+v"(kf[6]), "+v"(kf[7]));
    f32x16 sl = z16, su = z16;
#pragma unroll
    for (int ks = 0; ks < 4; ++ks) { su = __builtin_amdgcn_mfma_f32_32x32x16_bf16(kf[4 + ks], qf[ks], su, 0, 0, 0); sl = __builtin_amdgcn_mfma_f32_32x32x16_bf16(kf[ks], qf[ks], sl, 0, 0, 0); }
    float uu[16], ul[16], L[16];
#pragma unroll
    for (int r = 0; r < 16; ++r) { uu[r] = __builtin_amdgcn_exp2f(fminf(su[r], 115.f)); L[r] = __builtin_amdgcn_logf(1.f + uu[r]); }
    const bf16x8 lu0 = pack8(L), lu1 = pack8(L + 8);
    f32x16 iu = __builtin_amdgcn_mfma_f32_32x32x16_bf16(Mf[0], lu0, z16, 0, 0, 0); iu = __builtin_amdgcn_mfma_f32_32x32x16_bf16(Mf[1], lu1, iu, 0, 0, 0);
#pragma unroll
    for (int r = 0; r < 16; ++r) { ul[r] = __builtin_amdgcn_exp2f(fminf(sl[r], 115.f)); L[r] = __builtin_amdgcn_logf(1.f + ul[r]); }
    const bf16x8 ll0 = pack8(L), ll1 = pack8(L + 8);
    f32x16 il = __builtin_amdgcn_mfma_f32_32x32x16_bf16(Mf[0], ll0, z16, 0, 0, 0); il = __builtin_amdgcn_mfma_f32_32x32x16_bf16(Mf[1], ll1, il, 0, 0, 0);
    const LAS unsigned char* vp = Vb + ((lane >> 4) & 1) * 32 + (lane & 3) * 8 + (4 * hh + ((lane & 15) >> 2)) * 64;
    s16x4 vl[2][4], vh[2][4];
#pragma unroll
    for (int db = 0; db < 2; ++db)
#pragma unroll
        for (int g = 0; g < 4; ++g) { vl[db][g] = vtr(vp + db * 4096 + g * 1024); vh[db][g] = vtr(vp + db * 4096 + g * 1024 + 512); }
    float totu, totl;
    { const unsigned t0 = __float_as_uint(iu[0]); auto rr = __builtin_amdgcn_permlane32_swap(t0, t0, false, false); totu = __uint_as_float(rr[0]); }
    { const unsigned t0 = __float_as_uint(il[0]); auto rr = __builtin_amdgcn_permlane32_swap(t0, t0, false, false); totl = __uint_as_float(rr[0]); }
    float w[16];
#pragma unroll
    for (int r = 0; r < 16; ++r) w[r] = uu[r] * __builtin_amdgcn_exp2f(iu[r] + c);
    const bf16x8 pu0 = pack8(w), pu1 = pack8(w + 8);
    const float c1 = c + totu;
#pragma unroll
    for (int r = 0; r < 16; ++r) w[r] = ul[r] * __builtin_amdgcn_exp2f(il[r] + c1);
    const bf16x8 pl0 = pack8(w), pl1 = pack8(w + 8);
    c = c1 + totl;
#define ATT_VF(db, g) (bf16x8){vl[db][g][0], vl[db][g][1], vl[db][g][2], vl[db][g][3], vh[db][g][0], vh[db][g][1], vh[db][g][2], vh[db][g][3]}
    o0 = __builtin_amdgcn_mfma_f32_32x32x16_bf16(ATT_VF(0, 2), pu0, o0, 0, 0, 0); o1 = __builtin_amdgcn_mfma_f32_32x32x16_bf16(ATT_VF(1, 2), pu0, o1, 0, 0, 0);
    o0 = __builtin_amdgcn_mfma_f32_32x32x16_bf16(ATT_VF(0, 3), pu1, o0, 0, 0, 0); o1 = __builtin_amdgcn_mfma_f32_32x32x16_bf16(ATT_VF(1, 3), pu1, o1, 0, 0, 0);
    o0 = __builtin_amdgcn_mfma_f32_32x32x16_bf16(ATT_VF(0, 0), pl0, o0, 0, 0, 0); o1 = __builtin_amdgcn_mfma_f32_32x32x16_bf16(ATT_VF(1, 0), pl0, o1, 0, 0, 0);
    o0 = __builtin_amdgcn_mfma_f32_32x32x16_bf16(ATT_VF(0, 1), pl1, o0, 0, 0, 0); o1 = __builtin_amdgcn_mfma_f32_32x32x16_bf16(ATT_VF(1, 1), pl1, o1, 0, 0, 0);
#undef ATT_VF
}
__device__ __forceinline__ void attn_unit(const bf16* Q, const bf16* K, const bf16* V, bf16* Y, float* ssa, LAS unsigned char* lds, int b, int h, int qt, int wave, int lane) {
    const int r32 = lane & 31, hh = lane >> 5;
    const size_t rowbase = (size_t)b * SEQ; const int tq0 = 256 * qt + 32 * wave;
    const bf16* Kh = K + rowbase * 512 + h * 64; const bf16* Vh = V + rowbase * 512 + h * 64;
    const bf16* ksrc = Kh + (size_t)lane * 512 + wave * 8;
    const bf16* vsrc = Vh + (size_t)(16 * (wave & 3) + (lane >> 2)) * 512 + (wave >> 2) * 32 + (lane & 3) * 8;
#define ATT_STAGE(kt, buf) do { glds16(ksrc + (size_t)(kt) * 64 * 512, lds_addr(lds + LDS_K + (buf) * 8192 + wave * 1024)); \
                                glds16(vsrc + (size_t)(kt) * 64 * 512, lds_addr(lds + LDS_V + (buf) * 8192 + wave * 1024)); } while (0)
    const int kt_hi = 4 * qt + 3;
    const int nw = (kt_hi + 1 < NTW) ? kt_hi + 1 : NTW;
#pragma unroll
    for (int j = 0; j < NTW; ++j) if (j < nw) ATT_STAGE(kt_hi - j, j);
    bf16x8 qf[4];
    { const bf16* qp = Q + (rowbase + tq0 + r32) * 512 + h * 64 + 8 * hh;
#pragma unroll
      for (int ks = 0; ks < 4; ++ks) qf[ks] = *(const bf16x8*)(qp + 16 * ks); }
    bf16x8 Mf[2];
#pragma unroll
    for (int ks = 0; ks < 2; ++ks)
#pragma unroll
        for (int j = 0; j < 8; ++j) Mf[ks][j] = ((16 * ks + 8 * (j >> 2) + 4 * hh + (j & 3)) >= r32) ? (short)0xBF80 : (short)0;
    f32x16 o0 = {0.f, 0.f, 0.f, 0.f, 0.f, 0.f, 0.f, 0.f, 0.f, 0.f, 0.f, 0.f, 0.f, 0.f, 0.f, 0.f}, o1 = o0;
    float c = 0.f; bool done = false;
    LAS unsigned* flags = (LAS unsigned*)(lds + LDS_FLAG);
    asm volatile("" :: "v"(qf[0]), "v"(qf[1]), "v"(qf[2]), "v"(qf[3]));
    asm volatile("s_waitcnt vmcnt(0)\n\ts_barrier" ::: "memory");
#define ATT_TILE(kt, buf) do { const LAS unsigned char* Kb = lds + LDS_K + (buf) * 8192; const LAS unsigned char* Vb = lds + LDS_V + (buf) * 8192; \
            if (64 * (kt) + 32 < tq0) tile64(o0, o1, c, qf, Mf, Kb, Vb, r32, hh, lane);        \
            else { _Pragma("unroll") for (int kbl = 1; kbl >= 0; --kbl) { const int s0 = 64 * (kt) + 32 * kbl; \
                    if (s0 < tq0) block32<false>(o0, o1, c, qf, Mf, Kb, Vb, kbl, r32, hh, lane); \
                    else if (s0 == tq0) block32<true>(o0, o1, c, qf, Mf, Kb, Vb, kbl, r32, hh, lane); } } \
            done = __all(c < -ATT_THR) != 0; } while (0)
#pragma unroll 1
    for (int j = 0; j < nw; ++j) { if (done) break; const int kt = kt_hi - j; if (64 * kt >= tq0 + 32) continue;     ATT_TILE(kt, j); }
    if (lane == 0) flags[24 + wave] = done ? 1u : 0u;
    asm volatile("s_waitcnt lgkmcnt(0)\n\ts_barrier" ::: "memory");
    bool all_done;
    { const u32x4 f0 = *(const LAS u32x4*)(flags + 24), f1 = *(const LAS u32x4*)(flags + 28); all_done = (f0.x & f0.y & f0.z & f0.w & f1.x & f1.y & f1.z & f1.w) != 0u; }
    const int kt_s = kt_hi - nw;
    if (!all_done && kt_s >= 0) {
        ATT_STAGE(kt_s, 0); if (kt_s >= 1) ATT_STAGE(kt_s - 1, 1);
        int buf = 0, bprev = 2;
        for (int kt = kt_s; kt >= 0; --kt) {
            if (kt >= 1) asm volatile("s_waitcnt vmcnt(2) lgkmcnt(0)\n\ts_barrier" ::: "memory");
            else asm volatile("s_waitcnt vmcnt(0) lgkmcnt(0)\n\ts_barrier" ::: "memory");
            if (kt != kt_s) { const u32x4 f0 = *(const LAS u32x4*)(flags + bprev * 8), f1 = *(const LAS u32x4*)(flags + bprev * 8 + 4);
                if ((f0.x & f0.y & f0.z & f0.w & f1.x & f1.y & f1.z & f1.w) != 0u) break; }
            if (kt >= 2) ATT_STAGE(kt - 2, bprev);
            if (!done) ATT_TILE(kt, buf);
            if (lane == 0) flags[buf * 8 + wave] = done ? 1u : 0u;
            bprev = buf; buf = (buf == 2) ? 0 : buf + 1;
        }
        asm volatile("s_waitcnt vmcnt(0) lgkmcnt(0)\n\ts_barrier" ::: "memory");
    }
#undef ATT_TILE
    asm volatile("s_waitcnt vmcnt(0)" ::: "memory");
    float ss = 0.f;
    bf16* yp = Y + (rowbase + tq0 + r32) * DM + h * 64 + 4 * hh;
#pragma unroll
    for (int g = 0; g < 4; ++g) {
        const float a0 = o0[4 * g], a1 = o0[4 * g + 1], a2 = o0[4 * g + 2], a3 = o0[4 * g + 3], b0 = o1[4 * g], b1 = o1[4 * g + 1], b2 = o1[4 * g + 2], b3 = o1[4 * g + 3];
        ss += (a0 * a0 + a1 * a1) + (a2 * a2 + a3 * a3) + (b0 * b0 + b1 * b1) + (b2 * b2 + b3 * b3);
        *(unsigned long long*)(yp + 8 * g) = (unsigned long long)pg8::cvt_pk_bf16(a0, a1) | ((unsigned long long)pg8::cvt_pk_bf16(a2, a3) << 32);
        *(unsigned long long*)(yp + 32 + 8 * g) = (unsigned long long)pg8::cvt_pk_bf16(b0, b1) | ((unsigned long long)pg8::cvt_pk_bf16(b2, b3) << 32);
    }
    { const unsigned t0 = __float_as_uint(ss); auto rr = __builtin_amdgcn_permlane32_swap(t0, t0, false, false); ss = __uint_as_float(rr[0]) + __uint_as_float(rr[1]); }
    if (hh == 0) ssa[(rowbase + tq0 + r32) * 8 + h] = ss;
#undef ATT_STAGE
}
__device__ __forceinline__ void attn_phase(const Args& a, LAS unsigned char* lds, int wave, int lane, int G, int bx) {
    const bf16* Q = (const bf16*)(a.wsp() + WS_PROJ); const bf16* K = Q + PROJ_STRIDE; const bf16* V = K + PROJ_STRIDE;
    bf16* Y = (bf16*)((unsigned char*)a.outp() + DO_Y); float* ssa = (float*)(a.wsp() + WS_SSA);
    for (int u = bx; u < BATCH * NH * 16; u += G) {
        const int bh = u % 64, qt = (u / 64 + bh) % 16;
        attn_unit(Q, K, V, Y, ssa, lds, bh / NH, bh % NH, qt, wave, lane);
    }
}
}


namespace lru {
typedef short bf16x8 __attribute__((ext_vector_type(8)));
template <int CTRL> __device__ __forceinline__ float dpp_f(float v) { return __builtin_bit_cast(float, __builtin_amdgcn_update_dpp(0, __builtin_bit_cast(int, v), CTRL, 0xF, 0xF, true)); }
constexpr int WP = 64, NSTEP = SEQ / (8 * WP), XBUF = 8576  , WT = 2 * 8 * XBUF  , GRB = WT + 2048  ;
__device__ __forceinline__ void lru_item(const Args& a, LAS unsigned char* lds, int b, int cg, int wave, int lane) {
    const int g = cg >> 2, j0 = 16 * (cg & 3), ch0 = 16 * cg;
    const bf16* XR = (const bf16*)(a.wsp() + WS_PROJ) + 3 * PROJ_STRIDE + (size_t)b * SEQ * 512 + g * 64;
    const bf16* GR = (const bf16*)(a.wsp() + WS_PROJ) + 4 * PROJ_STRIDE + (size_t)b * SEQ * 512 + ch0;
    bf16* Y = (bf16*)((unsigned char*)a.outp() + DO_Y) + (size_t)b * SEQ * DM + 512 + ch0;
    float* ssl = (float*)(a.wsp() + WS_SSL) + (size_t)cg * NTOK + (size_t)b * SEQ;
    __syncthreads();
    const int c = lane & 15, pq = lane >> 4;
    bf16x8 wrf[4][2], wif[4][2];
    const int ch = ch0 + c;
    float rgb = a.inp(I_RGB)[ch], igb = a.inp(I_IGB)[ch];
    { const float* rw = a.inp(I_RGW) + (size_t)g * 4096 + j0 + c; const float* iw = a.inp(I_IGW) + (size_t)g * 4096 + j0 + c;
      const float* cwp = a.inp(I_CONVW) + g * 64; const float* cbp = a.inp(I_CONVB) + g * 64;
#pragma unroll
      for (int ks = 0; ks < 2; ++ks) { float wr_[8], wi_[8];
#pragma unroll
          for (int jj = 0; jj < 8; ++jj) { const int k = 32 * ks + 8 * pq + jj; wr_[jj] = rw[k * 64]; wi_[jj] = iw[k * 64]; }
#pragma unroll
          for (int j = 0; j < 4; ++j) { float tr[8], ti[8];
#pragma unroll
              for (int jj = 0; jj < 8; ++jj) { const float cwv = cwp[j * LRW + 32 * ks + 8 * pq + jj]; tr[jj] = cwv * wr_[jj]; ti[jj] = cwv * wi_[jj]; }
              wrf[j][ks] = att::pack8(tr); wif[j][ks] = att::pack8(ti); } }
      float sr = 0.f, si = 0.f;
#pragma unroll 1
      for (int k0 = 0; k0 < 64; k0 += 16) { float tr_[16], ti_[16], tb_[16];
#pragma unroll
          for (int k = 0; k < 16; ++k) { tb_[k] = cbp[k0 + k]; tr_[k] = rw[(k0 + k) * 64]; ti_[k] = iw[(k0 + k) * 64]; }
#pragma unroll
          for (int k = 0; k < 16; ++k) { sr += tb_[k] * tr_[k]; si += tb_[k] * ti_[k]; } }
      rgb += sr; igb += si; }
    float la2; { const float lam = a.inp(I_LAMBDA)[ch]; const float sp = fmaxf(-lam, 0.f) + log1pf(__expf(-fabsf(lam))); la2 = -8.0f * sp * 1.4426950408889634f; }
    float cwo[5];
#pragma unroll
    for (int jj = 0; jj < 4; ++jj) cwo[jj] = a.inp(I_CONVW)[jj * LRW + g * 64 + j0 + c];
    cwo[4] = a.inp(I_CONVB)[g * 64 + j0 + c];
    LAS unsigned char* xb = lds + wave * (2 * XBUF);
    LAS unsigned char* gb = lds + GRB + wave * 2048;
#define LRU_DMA(p0, buf) do { const bf16* s_ = XR + ((long)(p0) - 3 + (lane >> 3)) * 512 + 8 * (lane & 7); \
        _Pragma("unroll") for (int j_ = 0; j_ < 8; ++j_) glds16(s_ + (long)j_ * 8 * 512, lds_addr(xb + (buf) * XBUF + j_ * 1024)); \
        if (lane < 24) glds16(s_ + (long)8 * 8 * 512, lds_addr(xb + (buf) * XBUF + 8 * 1024)); } while (0)
#define LRU_DMA_GR(p0) do { const bf16* g_ = GR + (size_t)((p0) + (lane >> 1)) * 512 + 8 * (lane & 1); \
        glds16(g_, lds_addr(gb)); glds16(g_ + 32 * 512, lds_addr(gb + 1024)); } while (0)
    asm volatile("" :: "v"(wrf[0][0]), "v"(wrf[1][0]), "v"(wrf[2][0]), "v"(wrf[3][0]), "v"(wrf[0][1]), "v"(wrf[1][1]), "v"(wrf[2][1]), "v"(wrf[3][1]));
    asm volatile("" :: "v"(wif[0][0]), "v"(wif[1][0]), "v"(wif[2][0]), "v"(wif[3][0]), "v"(wif[0][1]), "v"(wif[1][1]), "v"(wif[2][1]), "v"(wif[3][1]));
    asm volatile("" :: "v"(cwo[0]), "v"(cwo[1]), "v"(cwo[2]), "v"(cwo[3]), "v"(cwo[4]), "v"(rgb), "v"(igb), "v"(la2));
    asm volatile("s_waitcnt vmcnt(0)" ::: "memory");
    float hc = 0.f;
    LRU_DMA(64 * wave, 0); LRU_DMA_GR(64 * wave);
    asm volatile("s_waitcnt vmcnt(0)" ::: "memory");
    if (wave == 0 && lane < 24) *(LAS u32x4*)(xb + lane * 16) = (u32x4){0u, 0u, 0u, 0u};
    asm volatile("s_waitcnt lgkmcnt(0)" ::: "memory");
    for (int st = 0; st < NSTEP; ++st) {
        const int buf = st & 1, p0 = st * (8 * WP) + WP * wave;
        if (st + 1 < NSTEP) LRU_DMA(p0 + 8 * WP, buf ^ 1);
        const LAS unsigned char* xs = xb + buf * XBUF;
        f32x4 rp[4], ip[4];
#pragma unroll
        for (int mt = 0; mt < 4; ++mt) { rp[mt] = (f32x4){0.f, 0.f, 0.f, 0.f}; ip[mt] = rp[mt]; }
#pragma unroll
        for (int mt = 0; mt < 4; ++mt) { const LAS unsigned char* ap = xs + (16 * (c >> 2) + 4 * mt + (c & 3)) * 128 + pq * 16;
            bf16x8 af[8];
#pragma unroll
            for (int q = 0; q < 8; ++q) af[q] = *(const LAS bf16x8*)(ap + (q >> 1) * 128 + (q & 1) * 64);
            asm volatile("" : "+v"(af[0]), "+v"(af[1]), "+v"(af[2]), "+v"(af[3]), "+v"(af[4]), "+v"(af[5]), "+v"(af[6]), "+v"(af[7]));
#pragma unroll
            for (int q = 0; q < 8; ++q) { rp[mt] = __builtin_amdgcn_mfma_f32_16x16x32_bf16(af[q], wrf[q >> 1][q & 1], rp[mt], 0, 0, 0); ip[mt] = __builtin_amdgcn_mfma_f32_16x16x32_bf16(af[q], wif[q >> 1][q & 1], ip[mt], 0, 0, 0); } }
        float av[16], bv[16]; float Al = 1.f, Hl = 0.f;
        { const LAS unsigned char* xo = xs + (16 * pq) * 128 + (j0 + c) * 2;
          unsigned xw[19];
#pragma unroll
          for (int q = 0; q < 19; ++q) xw[q] = *(const LAS bf16*)(xo + q * 128);
          asm volatile("" : "+v"(xw[0]), "+v"(xw[1]), "+v"(xw[2]), "+v"(xw[3]), "+v"(xw[4]), "+v"(xw[5]), "+v"(xw[6]), "+v"(xw[7]), "+v"(xw[8]), "+v"(xw[9]));
          asm volatile("" : "+v"(xw[10]), "+v"(xw[11]), "+v"(xw[12]), "+v"(xw[13]), "+v"(xw[14]), "+v"(xw[15]), "+v"(xw[16]), "+v"(xw[17]), "+v"(xw[18]));
#pragma unroll
          for (int idx = 0; idx < 16; ++idx) { const int mt = idx >> 2, r = idx & 3;
              const float w0 = __uint_as_float(xw[idx] << 16), w1 = __uint_as_float(xw[idx + 1] << 16), w2 = __uint_as_float(xw[idx + 2] << 16), w3 = __uint_as_float(xw[idx + 3] << 16);
              const float xcv = cwo[4] + (cwo[0] * w0 + cwo[1] * w1) + (cwo[2] * w2 + cwo[3] * w3);
              const float rr = __builtin_amdgcn_rcpf(1.f + __builtin_amdgcn_exp2f(-1.4426950408889634f * (rp[mt][r] + rgb))), ii = __builtin_amdgcn_rcpf(1.f + __builtin_amdgcn_exp2f(-1.4426950408889634f * (ip[mt][r] + igb)));
              const float aa = __builtin_amdgcn_exp2f(rr * la2);
              av[idx] = aa; bv[idx] = __builtin_amdgcn_sqrtf(fmaxf(1.f - aa * aa, 0.f)) * (ii * xcv);
              Hl = aa * Hl + bv[idx]; Al *= aa; } }
        float Ap = 1.f, Hp = 0.f;
#pragma unroll
        for (int k = 0; k < 3; ++k) { const float Ak = __shfl(Al, c + 16 * k), Hk = __shfl(Hl, c + 16 * k); if (k < pq) { Hp = Ak * Hp + Hk; Ap = Ap * Ak; } }
        typedef float f32x2 __attribute__((ext_vector_type(2)));
        if (pq == 3) *(LAS f32x2*)(lds + WT + ((buf * 8 + wave) * 16 + c) * 8) = (f32x2){Ap * Al, Al * Hp + Hl};
        asm volatile("s_waitcnt lgkmcnt(0)\n\ts_barrier" ::: "memory");
        if (st + 1 < NSTEP) asm volatile("s_waitcnt vmcnt(9)" ::: "memory"); else asm volatile("s_waitcnt vmcnt(0)" ::: "memory");
        float hin = hc;
        unsigned gw_[16];
#pragma unroll
        for (int q = 0; q < 16; ++q) gw_[q] = *(const LAS bf16*)(gb + (16 * pq + q) * 32 + c * 2);
        { f32x2 tw[8];
#pragma unroll
          for (int v = 0; v < 8; ++v) tw[v] = *(const LAS f32x2*)(lds + WT + ((buf * 8 + v) * 16 + c) * 8);
          asm volatile("" : "+v"(tw[0]), "+v"(tw[1]), "+v"(tw[2]), "+v"(tw[3]), "+v"(tw[4]), "+v"(tw[5]), "+v"(tw[6]), "+v"(tw[7]));
          asm volatile("" : "+v"(gw_[0]), "+v"(gw_[1]), "+v"(gw_[2]), "+v"(gw_[3]), "+v"(gw_[4]), "+v"(gw_[5]), "+v"(gw_[6]), "+v"(gw_[7]));
          asm volatile("" : "+v"(gw_[8]), "+v"(gw_[9]), "+v"(gw_[10]), "+v"(gw_[11]), "+v"(gw_[12]), "+v"(gw_[13]), "+v"(gw_[14]), "+v"(gw_[15]));
          float h = hc;
#pragma unroll
          for (int v = 0; v < 8; ++v) { if (v == wave) hin = h; h = tw[v].x * h + tw[v].y; }
          hc = h; }
        float h = Ap * hin + Hp;
        const size_t prow0 = (size_t)(p0 + 16 * pq); float smine = 0.f;
#pragma unroll
        for (int idx = 0; idx < 16; ++idx) {
            h = av[idx] * h + bv[idx];
            const float gr = __uint_as_float(gw_[idx] << 16);
            const float uu = 0.7978845608028654f * (gr + 0.044715f * gr * gr * gr);
            const float th = 1.f - 2.f * __builtin_amdgcn_rcpf(1.f + __builtin_amdgcn_exp2f(2.8853900817779268f * uu));
            const float y = h * (0.5f * gr * (1.f + th));
            Y[(prow0 + idx) * DM + c] = (bf16)f2bf(y);
            float s = y * y; s += dpp_f<0xB1>(s); s += dpp_f<0x4E>(s); s += dpp_f<0x141>(s); s += dpp_f<0x140>(s);
            if (c == idx) smine = s;
        }
        ssl[prow0 + c] = smine;
        if (st + 1 < NSTEP) { asm volatile("s_waitcnt lgkmcnt(0)" ::: "memory"); LRU_DMA_GR(p0 + 8 * WP); asm volatile("s_waitcnt vmcnt(16)" ::: "memory"); }
    }
#undef LRU_DMA
#undef LRU_DMA_GR
}
__device__ __forceinline__ void lru_phase(const Args& a, LAS unsigned char* lds, int wave, int lane, int G, int bx) {
    for (int it = bx; it < BATCH * 32; it += G) lru_item(a, lds, it / 32, it % 32, wave, lane);
    asm volatile("s_waitcnt vmcnt(0)" ::: "memory");
    __syncthreads();
}
}

constexpr int NPH = 9;
__device__ __forceinline__ Args kargs() {
    Args r{};
#if defined(__HIP_DEVICE_COMPILE__)
    static_assert(sizeof(Args) % 8 == 0, "Args is copied in 8-byte words");
    const __attribute__((address_space(4))) unsigned long long* q = (const __attribute__((address_space(4))) unsigned long long*)__builtin_amdgcn_kernarg_segment_ptr();
    unsigned long long* d = (unsigned long long*)&r;
#pragma unroll
    for (int i = 0; i < (int)(sizeof(Args) / 8); ++i) d[i] = q[i];
#endif
    return r;
}
__global__ void __launch_bounds__(NWAVES * 64, 2) fwd(Args args_unused) {
    extern __shared__ __attribute__((aligned(16))) unsigned char lds_[];
    LAS unsigned char* lds = (LAS unsigned char*)lds_;
    volatile LAS unsigned* MISC = (volatile LAS unsigned*)(lds + MISC_OFF);
    const int wave = __builtin_amdgcn_readfirstlane(threadIdx.x >> 6);
#define lane lane_id()
#define tid (wave * 64 + lane_id())
    const int G = gridDim.x; const int bx = blockIdx.x; const int vcu = (G % 8 == 0) ? (bx % 8) * (G / 8) + bx / 8 : bx;
    for (int u = threadIdx.x; u < (LDS_BYTES - LDSCTL_OFF) / 4; u += NWAVES * 64) ((LAS unsigned*)(lds + LDSCTL_OFF))[u] = 0u;
    __syncthreads();
    int lo, hi; unsigned* barw;
    { const Args a0 = kargs(); lo = a0.ph_lo; hi = a0.ph_hi; barw = (unsigned*)(a0.wsp() + WS_CTL) + CW_BAR + a0.li * XCD_BAR_WORDS; }
    const bool multi = (hi - lo) > 1;
    XcdBarrier bar; bar.bar = barw; bar.x = 0; bar.st = nullptr;
    if (multi) bar = xcd_barrier_post(barw, MISC + 8);
#define IN(k) (lo <= (k) && (k) < hi)
#define BOTH(k) (IN(k) && IN((k) + 1))
    if (IN(0)) { const Args args = kargs();     p0_adaln(args, lds, tid, G); if (BOTH(0)) xcd_barrier(bar, wave); }
    if (IN(1)) { const Args args = kargs();     p1_prep(args, lds, tid, lane, wave, vcu, G); if (BOTH(1)) xcd_barrier(bar, wave); }
    if (IN(2)) { const Args args = kargs();
        pg8::StaticOrder S; S.init(NTOK, DIN, G, bx, args.wsp() + WS_WINT, DM);
        pg8::EpiProj E{(bf16*)(args.wsp() + WS_PROJ)};
        pg8::gemm_phase<pg8::EpiProj, pg8::StaticOrder, true>(lds, args.wsp() + WS_XN, (unsigned)NTOK * DM * 2u, args.wsp() + WS_WINT, (unsigned)DIN * DM * 2u, DM * 2, S, E, wave);
        if (BOTH(2)) xcd_barrier(bar, wave);
    }
    if (IN(3)) { const Args args = kargs();
        lru::lru_phase(args, lds, wave, lane, G, bx);
        att::attn_phase(args, lds, wave, lane, G, bx);
        if (BOTH(3)) xcd_barrier(bar, wave);
    }
    if (IN(4)) { const Args args = kargs();
        pg8::StaticOrder S; S.init(NTOK, DM, G, bx, args.wsp() + WS_WOUTT, DM);
        LAS float* rst = (LAS float*)(lds + TAB_OFF);
        { const float* ssa = (const float*)(args.wsp() + WS_SSA); const float* ssl = (const float*)(args.wsp() + WS_SSL);
          for (int ui = 0; ui < 8; ++ui) { pg8::Unit u; if (!S.next(ui, u)) break;
              const int row = tid & 255, which = tid >> 8; const size_t grow = (size_t)u.pm * 256 + row; float s = 0.f;
              if (which == 0) { const f32x4 p0 = *(const f32x4*)(ssa + grow * 8), p1 = *(const f32x4*)(ssa + grow * 8 + 4); s = ((p0.x + p0.y) + (p0.z + p0.w)) + ((p1.x + p1.y) + (p1.z + p1.w)); }
              else { for (int q = 0; q < 32; ++q) s += ssl[(size_t)q * NTOK + grow]; }
              rst[(ui * 256 + row) * 2 + which] = rsqrtf(s * (1.f / 512.f) + EPS); } }
        __syncthreads();
        pg8::EpiOut E{args.inp(I_X), (const float*)(args.wsp() + WS_MOD), (bf16*)(args.wsp() + WS_X1B), (float*)(args.wsp() + WS_SSX), rst};
        pg8::gemm_phase<pg8::EpiOut, pg8::StaticOrder, true>(lds, (const unsigned char*)args.outp() + DO_Y, (unsigned)NTOK * DM * 2u, args.wsp() + WS_WOUTT, (unsigned)DM * DM * 2u, DM * 2, S, E, wave);
        if (BOTH(4)) xcd_barrier(bar, wave);
    }
    if (IN(5)) { const Args args = kargs();     p5_router(args, lds, tid, lane, wave, G); if (BOTH(5)) xcd_barrier(bar, wave); }
    if (IN(6)) { const Args args = kargs();
        const pg8::MoeTables T = pg8::moe_tables(lds + TAB_OFF, (const unsigned*)(args.wsp() + WS_CTL) + CW_CNT, tid);
        pg8::MoeOrder S{(const char*)(args.wsp() + WS_WGU), 8, 2, T, bx % 8, bx / 8, G / 8, 0};
        S.load_entries((const int*)(args.wsp() + WS_LIST), nullptr, tid);
        pg8::EpiGU E{T.ent, args.inp(I_BG), args.inp(I_BU), args.wsp() + WS_ACT, (LAS const float*)(lds + BIAS_OFF)};
        pg8::gemm_phase<pg8::EpiGU, pg8::MoeOrder, true>(lds, (const unsigned char*)args.outp() + DO_H2, (unsigned)NTOK * DM, args.wsp() + WS_WGU, (unsigned)NE * 2u * DE * DM, DM, S, E, wave);
        if (BOTH(6)) xcd_barrier(bar, wave);
    }
    if (IN(7)) { const Args args = kargs();
        const pg8::MoeTables T = pg8::moe_tables(lds + TAB_OFF, (const unsigned*)(args.wsp() + WS_CTL) + CW_CNT, tid);
        pg8::MoeOrder S{(const char*)(args.wsp() + WS_WDT), 4, 0, T, bx % 8, bx / 8, G / 8, 1};
        S.load_entries((const int*)(args.wsp() + WS_LIST), (const float*)(args.wsp() + WS_PASG), tid);
        pg8::EpiDown E{T.ent, args.inp(I_BD), T.pw, (unsigned char*)args.outp(), (LAS const float*)(lds + BIAS_OFF)};
        pg8::gemm_phase<pg8::EpiDown, pg8::MoeOrder, true>(lds, args.wsp() + WS_ACT, (unsigned)NASG * DE, args.wsp() + WS_WDT, (unsigned)NE * DM * DE, DE, S, E, wave);
        if (BOTH(7)) xcd_barrier(bar, wave);
    }
    if (IN(8)) { const Args args = kargs();     p8_final(args, lane, wave, vcu, G); }
#undef IN
#undef BOTH
#undef lane
#undef tid
}

extern "C" void kernel_launch(void* const* d_in, const int* in_sizes, int n_in, void* d_out, int out_size, void* d_ws, size_t ws_size, hipStream_t stream) {
    static int grid = 0;
    if (grid == 0) {
        if (n_in != 26 || out_size != NTOK * DM || ws_size < WS_END) { fprintf(stderr, "kernel_launch: unexpected shapes (n_in %d out %d ws %zu)\n", n_in, out_size, ws_size); grid = -1; return; }
        int dev = 0, cus = 0;
        if (hipGetDevice(&dev) != hipSuccess || hipDeviceGetAttribute(&cus, hipDeviceAttributeMultiprocessorCount, dev) != hipSuccess) { grid = -1; return; }
        if (hipFuncSetAttribute((const void*)fwd, hipFuncAttributeMaxDynamicSharedMemorySize, LDS_BYTES) != hipSuccess) { grid = -1; return; }
        int per_cu = 0;
        (void)hipOccupancyMaxActiveBlocksPerMultiprocessor(&per_cu, (const void*)fwd, NWAVES * 64, LDS_BYTES);
        (void)hipGetLastError();
        grid = cus;
    }
    if (grid < 0) return;
    (void)hipMemsetAsync((char*)d_ws + WS_CTL, 0, CTL_ZERO_BYTES, stream);
    Args a{};
    for (int i = 0; i < 26; ++i) a.in[i] = (KGAS const float*)d_in[i];
    a.out = (KGAS float*)d_out; a.ws = (KGAS unsigned char*)d_ws;
    a.ph_lo = 0; a.ph_hi = NPH; a.li = 0; a.pad = 0;
    hipLaunchKernelGGL(fwd, dim3(grid), dim3(NWAVES * 64), LDS_BYTES, stream, a);
}
```

```cpp
#include <hip/hip_runtime.h>
#include <cstdio>
#include <cstdint>

constexpr int BATCH = 8, SEQ = 4096, DM = 1024, NTOK = BATCH * SEQ;
constexpr int DIN = 2560, SBW = 512, LRW = 512, NH = 8, HD = 64;
constexpr int NE = 32, TOPK = 4, NASG = NTOK * TOPK, DE = 1024;
constexpr float EPS = 1e-6f;
constexpr float C2 = 0.125f * 1.4426950408889634f;
constexpr float LN2 = 0.6931471805599453f;

constexpr size_t MiB = 1u << 20;
constexpr size_t WS_CTL = 0, CTL_ZERO_BYTES = 1 * MiB;
constexpr size_t WS_MOD = 1 * MiB;
constexpr size_t WS_WR = 1 * MiB + 256 * 1024;
constexpr size_t WS_PASG = 1 * MiB + 512 * 1024;
constexpr size_t WS_SSA = 2 * MiB;
constexpr size_t WS_SSL = 3 * MiB;
constexpr size_t WS_SSX = 7 * MiB;
constexpr size_t WS_LIST = 9 * MiB;
constexpr size_t WS_RA = 18 * MiB;
constexpr size_t WS_XN = WS_RA, WS_PROJ = WS_RA + 64 * MiB, WS_WINT = WS_RA + 224 * MiB, WS_WOUTT = WS_RA + 229 * MiB, WS_ACT = WS_RA;
constexpr size_t WS_RB = WS_RA + 256 * MiB;
constexpr size_t WS_WGU = WS_RB;
constexpr size_t WS_WDT = WS_RB + 128 * MiB;
constexpr size_t WS_X1B = WS_WDT + 64 * MiB;
constexpr size_t WS_END = WS_X1B + 64 * MiB;
constexpr size_t PROJ_STRIDE = (size_t)NTOK * 512;
constexpr size_t DO_Y = 0, DO_H2 = 64 * MiB;
constexpr int CW_CNT = 64;
constexpr int CW_BAR = 4096;

typedef unsigned short bf16;
typedef unsigned u32x4 __attribute__((ext_vector_type(4)));
typedef float f32x4 __attribute__((ext_vector_type(4)));

__device__ __forceinline__ float bf2f(bf16 v) { return __uint_as_float((unsigned)v << 16); }
__device__ __forceinline__ unsigned f2bf(float f) { unsigned u = __float_as_uint(f); return (u + 0x7fffu + ((u >> 16) & 1u)) >> 16; }
__device__ __forceinline__ unsigned pk2(float lo, float hi) { return f2bf(lo) | (f2bf(hi) << 16); }
__device__ __forceinline__ unsigned pk4_fp8(float a, float b, float c, float d) {
    a = fminf(fmaxf(a, -448.f), 448.f); b = fminf(fmaxf(b, -448.f), 448.f); c = fminf(fmaxf(c, -448.f), 448.f); d = fminf(fmaxf(d, -448.f), 448.f);
    int r = 0; r = __builtin_amdgcn_cvt_pk_fp8_f32(a, b, r, false); r = __builtin_amdgcn_cvt_pk_fp8_f32(c, d, r, true); return (unsigned)r; }
__device__ __forceinline__ unsigned pk4_fp8_raw(float a, float b, float c, float d) {
    int r = 0; r = __builtin_amdgcn_cvt_pk_fp8_f32(a, b, r, false); r = __builtin_amdgcn_cvt_pk_fp8_f32(c, d, r, true); return (unsigned)r; }
__device__ __forceinline__ unsigned pk4_fp8_m3(float a, float b, float c, float d) {
    a = __builtin_amdgcn_fmed3f(a, -448.f, 448.f); b = __builtin_amdgcn_fmed3f(b, -448.f, 448.f); c = __builtin_amdgcn_fmed3f(c, -448.f, 448.f); d = __builtin_amdgcn_fmed3f(d, -448.f, 448.f);
    int r = 0; r = __builtin_amdgcn_cvt_pk_fp8_f32(a, b, r, false); r = __builtin_amdgcn_cvt_pk_fp8_f32(c, d, r, true); return (unsigned)r; }
constexpr float W8_SCALE = 1.f;
__device__ __forceinline__ float sigmoidf_(float x) { return 1.f / (1.f + __expf(-x)); }
__device__ __forceinline__ float gelu_tanh(float x) { const float u = 0.7978845608028654f * (x + 0.044715f * x * x * x); return 0.5f * x * (1.f + tanhf(u)); }
__device__ __forceinline__ void unpack8(const u32x4 v, float* f) {
    f[0] = __uint_as_float(v.x << 16); f[1] = __uint_as_float(v.x & 0xffff0000u); f[2] = __uint_as_float(v.y << 16); f[3] = __uint_as_float(v.y & 0xffff0000u);
    f[4] = __uint_as_float(v.z << 16); f[5] = __uint_as_float(v.z & 0xffff0000u); f[6] = __uint_as_float(v.w << 16); f[7] = __uint_as_float(v.w & 0xffff0000u);
}
__device__ __forceinline__ float dot8(const u32x4 a, const u32x4 b) {
    float x[8], y[8]; unpack8(a, x); unpack8(b, y); float s = 0.f;
#pragma unroll
    for (int i = 0; i < 8; ++i) s += x[i] * y[i];
    return s;
}

#if defined(__HIP_DEVICE_COMPILE__)
#define KGAS __attribute__((address_space(1)))
#else
#define KGAS
#endif
struct Args {
    KGAS const float* in[26]; KGAS float* out; KGAS unsigned char* ws; int ph_lo, ph_hi, li, pad;
    __host__ __device__ __forceinline__ const float* inp(int i) const { return (const float*)in[i]; }
    __host__ __device__ __forceinline__ float* outp() const { return (float*)out; }
    __host__ __device__ __forceinline__ unsigned char* wsp() const { return (unsigned char*)ws; }
};
enum { I_X = 0, I_C, I_ADAW, I_ADAB, I_MIXG, I_WIN, I_CONVW, I_CONVB, I_RGW, I_RGB, I_IGW, I_IGB, I_LAMBDA, I_AOG, I_LOG, I_WOUT, I_FFNG, I_RW, I_RB, I_WG, I_BG, I_WU, I_BU, I_WD, I_BD, I_FING };

#define GAS __attribute__((address_space(1)))
#define LAS __attribute__((address_space(3)))
typedef GAS unsigned gu32;
#define RLX_AGENT __ATOMIC_RELAXED, __HIP_MEMORY_SCOPE_AGENT
#define LDS_WAIT() asm volatile("s_waitcnt lgkmcnt(0)" ::: "memory")
#define VM_WAIT() asm volatile("s_waitcnt vmcnt(0)" ::: "memory")
constexpr int NWAVES = 8;
constexpr int RING_BYTES = 131072, TAB_OFF = RING_BYTES, LDS_BYTES = 161792, LDSCTL_OFF = LDS_BYTES - 512, MISC_OFF = LDSCTL_OFF + 320, BIAS_OFF = LDSCTL_OFF - 2048;

#define XB_TMO      128
#define XB_XCNT(j)  (256  + 64 * (j))
#define XB_XSUB(j)  (1280 + 64 * (j))
#define XB_XGEN(j)  (2304 + 64 * (j))
#define XB_TOP      3328
#define XB_TOPGEN   3392
#define XCD_BAR_WORDS 3456
#define XB_SPIN_CAP (1u << 18)
__device__ __forceinline__ unsigned xb_ld(unsigned* p)              { return __hip_atomic_load(p, __ATOMIC_RELAXED, __HIP_MEMORY_SCOPE_AGENT); }
__device__ __forceinline__ unsigned xb_add(unsigned* p, unsigned v) { return __hip_atomic_fetch_add(p, v, __ATOMIC_RELAXED, __HIP_MEMORY_SCOPE_AGENT); }
__device__ __forceinline__ unsigned xb_xcc_id() { return (unsigned)__builtin_amdgcn_s_getreg((3 << 11) | 20) & 0xFu; }
#define XB_SPIN(cond, bar) do { unsigned _sp = 0; while (cond) { __builtin_amdgcn_s_sleep(1); \
    if ((++_sp & 255u) == 0u) { if (xb_ld(&(bar)[XB_TMO])) break; if (_sp > XB_SPIN_CAP) { atomicAdd(&(bar)[XB_TMO], 1u); break; } } } } while (0)
struct XcdBarrier { unsigned* bar; unsigned x; volatile LAS unsigned* st; };
__device__ __forceinline__ XcdBarrier xcd_barrier_post(unsigned* bar, volatile LAS unsigned* st) {
    XcdBarrier b; b.bar = bar; b.x = xb_xcc_id(); b.st = st;
    if (threadIdx.x == 0) (void)xb_add(&bar[XB_XCNT(b.x)], 1u);
    return b;
}
__device__ __forceinline__ void xcd_barrier_complete(unsigned* bar, unsigned x, unsigned& nloc, unsigned& nx) {
    const unsigned G = gridDim.x * gridDim.y * gridDim.z;
    unsigned sum, cnt, mine, sp = 0u;
    for (;;) {
        sum = 0u; cnt = 0u; mine = 0u;
#pragma unroll
        for (unsigned j = 0; j < 16; ++j) { const unsigned c = xb_ld(&bar[XB_XCNT(j)]); sum += c; cnt += (c > 0u) ? 1u : 0u; mine = (j == x) ? c : mine; }
        if (sum == G) break;
        __builtin_amdgcn_s_sleep(1);
        if ((++sp & 255u) == 0u) { if (xb_ld(&bar[XB_TMO])) break; if (sp > XB_SPIN_CAP) { atomicAdd(&bar[XB_TMO], 1u); break; } }
    }
    nloc = mine > 0u ? mine : 1u; nx = cnt > 0u ? cnt : 1u;
}
__device__ __forceinline__ int lane_id();
__device__ __forceinline__ void xcd_barrier(const XcdBarrier& b, const int wave_) {
    asm volatile("s_waitcnt vmcnt(0)" ::: "memory");
    __syncthreads();
    if (wave_ == 0 && lane_id() == 0) {
        unsigned* bar = b.bar;
        __builtin_amdgcn_s_waitcnt(0);
        unsigned nloc = b.st[0], nx = b.st[1];
        if (nloc == 0u) { xcd_barrier_complete(bar, b.x, nloc, nx); b.st[0] = nloc; b.st[1] = nx; }
        const unsigned old = xb_add(&bar[XB_XSUB(b.x)], 1u);
        const unsigned gen = old / nloc;
        if (old + 1u == (gen + 1u) * nloc) {
            __builtin_amdgcn_fence(__ATOMIC_RELEASE, "agent");
            asm volatile("s_waitcnt vmcnt(0)" ::: "memory");
            const unsigned og = xb_add(&bar[XB_TOP], 1u);
            const unsigned tg = og / nx;
            if (og + 1u == (tg + 1u) * nx) xb_add(&bar[XB_TOPGEN], 1u);
            else XB_SPIN(xb_ld(&bar[XB_TOPGEN]) == tg, bar);
            __builtin_amdgcn_fence(__ATOMIC_ACQUIRE, "agent");
            xb_add(&bar[XB_XGEN(b.x)], 1u);
            asm volatile("s_waitcnt vmcnt(0)" ::: "memory");
        } else {
            XB_SPIN(xb_ld(&bar[XB_XGEN(b.x)]) == gen, bar);
            __builtin_amdgcn_fence(__ATOMIC_ACQUIRE, "agent");
            asm volatile("s_waitcnt vmcnt(0)" ::: "memory");
        }
    }
    __syncthreads();
}

__device__ __forceinline__ int lane_id() { int r; asm volatile("v_mbcnt_lo_u32_b32 %0, -1, 0\n\tv_mbcnt_hi_u32_b32 %0, -1, %0" : "=v"(r)); return r; }
__device__ __forceinline__ float wave_sum(float v) {
#pragma unroll
    for (int o = 1; o < 64; o <<= 1) v += __shfl_xor(v, o);
    return v;
}

__device__ __forceinline__ void p0_adaln(const Args& a, LAS unsigned char* lds, int tid, int G) {
    LAS float* cact = (LAS float*)lds;
    LAS float* part = (LAS float*)(lds + 32768);
    const float* c = a.inp(I_C);
    for (int i = tid; i < 8 * 1024; i += 512) { const int b = i >> 10, k = i & 1023; const float v = c[i]; cact[k * 8 + b] = v / (1.f + __expf(-v)); }
    __syncthreads();
    const float* W = a.inp(I_ADAW); float* mod = (float*)(a.wsp() + WS_MOD);
    const int col = tid % 24, ks = tid / 24;
    for (int ch = blockIdx.x; ch < 6144 / 24; ch += G) {
        const int n = ch * 24 + col;
        if (ks < 21) {
            float acc[8];
#pragma unroll
            for (int b = 0; b < 8; ++b) acc[b] = 0.f;
#pragma unroll 7
            for (int k = ks; k < 1024; k += 21) {
                const float w = W[(size_t)k * 6144 + n];
                const f32x4 c0 = *(const LAS f32x4*)(cact + k * 8), c1 = *(const LAS f32x4*)(cact + k * 8 + 4);
                acc[0] += w * c0.x; acc[1] += w * c0.y; acc[2] += w * c0.z; acc[3] += w * c0.w;
                acc[4] += w * c1.x; acc[5] += w * c1.y; acc[6] += w * c1.z; acc[7] += w * c1.w;
            }
#pragma unroll
            for (int b = 0; b < 8; ++b) part[(ks * 24 + col) * 8 + b] = acc[b];
        }
        __syncthreads();
        if (tid < 192) { const int cc = tid >> 3, b = tid & 7; float s = a.inp(I_ADAB)[ch * 24 + cc];
            for (int q = 0; q < 21; ++q) s += part[(q * 24 + cc) * 8 + b];
            mod[b * 6144 + ch * 24 + cc] = s; }
        __syncthreads();
    }
}

struct P1Item { const float* W; const float* ks; unsigned char* dst; int N, k0, n0, e8, which, fp8; };
__device__ __forceinline__ P1Item p1_decode(const Args& a, int it) {
    constexpr int I_IN = 16 * (DIN / 256), I_OUT = 16 * 4, I_EXP = 8 * 4;
    P1Item d; d.ks = nullptr; d.fp8 = 0; d.e8 = 0; d.which = 0;
    if (it < I_IN) { const int nb = DIN / 256; d.W = a.inp(I_WIN); d.N = DIN; d.k0 = 64 * (it / nb); d.n0 = 256 * (it % nb); d.dst = a.wsp() + WS_WINT; return d; }
    it -= I_IN;
    if (it < I_OUT) { d.W = a.inp(I_WOUT); d.N = DM; d.k0 = 64 * (it / 4); d.n0 = 256 * (it % 4); d.dst = a.wsp() + WS_WOUTT;
        d.ks = (d.k0 < 512) ? a.inp(I_AOG) : (a.inp(I_LOG) - 512); return d; }
    it -= I_OUT;
    const int mat = it / I_EXP, q = it % I_EXP, e = mat / 3; d.which = mat % 3;
    d.k0 = 128 * (q / 4); d.n0 = 256 * (q % 4); d.fp8 = 1; d.N = 1024; d.e8 = e;
    if (d.which == 2) { d.W = a.inp(I_WD) + (size_t)e * DE * DM; d.dst = a.wsp() + WS_WDT; }
    else { d.W = a.inp(d.which == 0 ? I_WG : I_WU) + (size_t)e * DM * DE; d.dst = a.wsp() + WS_WGU; }
    return d;
}
__device__ __forceinline__ void p1_prep(const Args& a, LAS unsigned char* lds, int tid, int lane, int wave, int vcu, int G) {
    constexpr int NIT = 16 * (DIN / 256) + 16 * 4 + 96 * 8 * 4;
    const int col4 = (tid & 63) * 4, rb = tid >> 6;
    f32x4 tv[16];
    P1Item cur = p1_decode(a, (int)blockIdx.x < NIT ? (int)blockIdx.x : 0);
#define P1_LOAD(d) do { _Pragma("unroll") for (int i = 0; i < 16; ++i) { int kk_ = (d).k0 + rb + 8 * i; kk_ = kk_ < 1023 ? kk_ : 1023;     \
        tv[i] = *(const f32x4*)((d).W + (size_t)kk_ * (d).N + (d).n0 + col4); } } while (0)
    if ((int)blockIdx.x < NIT) P1_LOAD(cur);
    int buf = 0;
    for (int it = blockIdx.x; it < NIT; it += G) {
        LAS unsigned char* T = lds + buf * 32768;
        if (cur.fp8) {
#pragma unroll
            for (int i = 0; i < 16; ++i) *(LAS unsigned*)(T + (rb + 8 * i) * 256 + col4) = pk4_fp8(tv[i].x * W8_SCALE, tv[i].y * W8_SCALE, tv[i].z * W8_SCALE, tv[i].w * W8_SCALE);
        } else {
#pragma unroll
            for (int i = 0; i < 8; ++i) { f32x4 v = tv[i]; if (cur.ks) v = v * cur.ks[cur.k0 + rb + 8 * i];
                typedef unsigned u32x2 __attribute__((ext_vector_type(2))); *(LAS u32x2*)(T + (rb + 8 * i) * 512 + col4 * 2) = (u32x2){pk2(v.x, v.y), pk2(v.z, v.w)}; }
        }
        const P1Item me = cur;
        const int itn = it + G;
        if (itn < NIT) { cur = p1_decode(a, itn); P1_LOAD(cur); }
        __syncthreads();
        { const int n = tid & 255, hf = tid >> 8, ng = me.n0 + n;
          u32x4 o[4];
          if (me.fp8) {
#pragma unroll
              for (int q = 0; q < 4; ++q) { unsigned w4[4];
#pragma unroll
                  for (int r = 0; r < 4; ++r) { const LAS unsigned char* p = T + (hf * 64 + q * 16 + r * 4) * 256 + n;
                      w4[r] = (unsigned)p[0] | ((unsigned)p[256] << 8) | ((unsigned)p[512] << 16) | ((unsigned)p[768] << 24); }
                  o[q] = (u32x4){w4[0], w4[1], w4[2], w4[3]}; }
              LAS unsigned char* S = lds + 65536;
#pragma unroll
              for (int q = 0; q < 4; ++q) *(LAS u32x4*)(S + n * 144 + hf * 64 + q * 16) = o[q];
              __syncthreads();
#pragma unroll
              for (int i = 0; i < 4; ++i) { const int id = tid + 512 * i, rw = id >> 3, c = id & 7, ngr = me.n0 + rw;
                  const size_t orow = (me.which == 2) ? (size_t)me.e8 * DM + ngr : (size_t)(me.e8 * 8 + ngr / 128) * 256 + (ngr % 128) + (me.which ? 128 : 0);
                  *(u32x4*)(me.dst + orow * DM + me.k0 + c * 16) = *(const LAS u32x4*)(S + rw * 144 + c * 16); }
          } else {
#pragma unroll
              for (int q = 0; q < 4; ++q) { unsigned w4[4];
#pragma unroll
                  for (int r = 0; r < 4; ++r) { const LAS unsigned short* p = (const LAS unsigned short*)(T + (hf * 32 + q * 8 + r * 2) * 512 + n * 2);
                      w4[r] = (unsigned)p[0] | ((unsigned)p[256] << 16); }
                  o[q] = (u32x4){w4[0], w4[1], w4[2], w4[3]}; }
              LAS unsigned char* S = lds + 65536;
#pragma unroll
              for (int q = 0; q < 4; ++q) *(LAS u32x4*)(S + n * 144 + hf * 64 + q * 16) = o[q];
              __syncthreads();
#pragma unroll
              for (int i = 0; i < 4; ++i) { const int id = tid + 512 * i, rw = id >> 3, c = id & 7;
                  *(u32x4*)((unsigned char*)((bf16*)me.dst + (size_t)(me.n0 + rw) * DM + me.k0) + c * 16) = *(const LAS u32x4*)(S + rw * 144 + c * 16); }
          } }
        buf ^= 1;
    }
#undef P1_LOAD
    __syncthreads();
    const int gw = vcu * NWAVES + wave, NGW = G * NWAVES;
    { bf16* wr = (bf16*)(a.wsp() + WS_WR);
      for (int i = blockIdx.x * 512 + tid; i < 32 * 1024; i += G * 512) { const int e = i >> 10, k = i & 1023; const float w = a.inp(I_RW)[k * 32 + e];
          const unsigned hi = f2bf(w); wr[i] = (bf16)hi; wr[32768 + i] = (bf16)f2bf(w - __uint_as_float(hi << 16)); } }
    const float* mod = (const float*)(a.wsp() + WS_MOD);
    f32x4 v0[4], v1[4], w0[4], w1[4];
    if (gw < NTOK) {
#pragma unroll
        for (int j = 0; j < 4; ++j) { v0[j] = ((const f32x4*)(a.inp(I_X) + (size_t)gw * DM) + lane)[64 * j]; v1[j] = ((const f32x4*)(a.inp(I_X) + (size_t)(gw + NGW < NTOK ? gw + NGW : gw) * DM) + lane)[64 * j]; }
    }
    for (int m0 = gw; m0 < NTOK; m0 += 2 * NGW) {
        const int m1 = m0 + NGW; const bool two = m1 < NTOK;
        const int n0 = m0 + 2 * NGW, n1 = n0 + NGW;
        if (n0 < NTOK) {
#pragma unroll
            for (int j = 0; j < 4; ++j) { w0[j] = ((const f32x4*)(a.inp(I_X) + (size_t)n0 * DM) + lane)[64 * j]; w1[j] = ((const f32x4*)(a.inp(I_X) + (size_t)(n1 < NTOK ? n1 : n0) * DM) + lane)[64 * j]; }
        }
        float s0 = 0.f, s1 = 0.f;
#pragma unroll
        for (int j = 0; j < 4; ++j) { s0 += (v0[j].x * v0[j].x + v0[j].y * v0[j].y) + (v0[j].z * v0[j].z + v0[j].w * v0[j].w); s1 += (v1[j].x * v1[j].x + v1[j].y * v1[j].y) + (v1[j].z * v1[j].z + v1[j].w * v1[j].w); }
        const float rs0 = rsqrtf(wave_sum(s0) * (1.f / DM) + EPS), rs1 = rsqrtf(wave_sum(s1) * (1.f / DM) + EPS);
#pragma unroll
        for (int q = 0; q < 2; ++q) { if (q == 1 && !two) break;
            const int m = q ? m1 : m0; const int b = m / SEQ; const float rs = q ? rs1 : rs0;
            unsigned long long* o8 = (unsigned long long*)((bf16*)(a.wsp() + WS_XN) + (size_t)m * DM) + lane;
#pragma unroll
            for (int j = 0; j < 4; ++j) {
                const int k = 4 * lane + 256 * j;
                const f32x4 g = *(const f32x4*)(a.inp(I_MIXG) + k), sh = *(const f32x4*)(mod + b * 6144 + k), sc = *(const f32x4*)(mod + b * 6144 + 1024 + k);
                const f32x4 h = ((q ? v1[j] : v0[j]) * rs * g) * (sc + 1.f) + sh;
                o8[64 * j] = (unsigned long long)pk2(h.x, h.y) | ((unsigned long long)pk2(h.z, h.w) << 32);
            } }
#pragma unroll
        for (int j = 0; j < 4; ++j) { v0[j] = w0[j]; v1[j] = w1[j]; }
    }
}

__device__ __forceinline__ void p8_final(const Args& a, LAS unsigned char* lds, int lane, int wave, int vcu, int G) {
    typedef float f32x2 __attribute__((ext_vector_type(2)));
    const int gw = vcu * NWAVES + wave, NGW = G * NWAVES;
    const float* mod = (const float*)(a.wsp() + WS_MOD);
    u32x4 cx[2], cy[4], nx[2], ny[4];
#define P8_LOAD(m_, X, Y) do { const u32x4* x1_ = (const u32x4*)((const bf16*)(a.wsp() + WS_X1B) + (size_t)(m_) * DM) + 2 * lane; const u32x4* y_ = (const u32x4*)((const unsigned char*)a.outp() + (size_t)(m_) * 4096) + lane; \
        X[0] = x1_[0]; X[1] = x1_[1]; Y[0] = y_[0]; Y[1] = y_[64]; Y[2] = y_[128]; Y[3] = y_[192]; } while (0)
    if (gw < NTOK) P8_LOAD(gw, cx, cy);
    for (int m = gw; m < NTOK; m += NGW) {
        const int b = m / SEQ; const int mn = m + NGW;
        if (mn < NTOK) P8_LOAD(mn, nx, ny);
        float v[16], xv[16]; float s = 0.f;
        unpack8(cx[0], xv); unpack8(cx[1], xv + 8);
        const float* gp = mod + b * 6144 + 5120 + 16 * lane;
#pragma unroll
        for (int q = 0; q < 4; ++q) {
            const unsigned w0 = cy[0][q], w1 = cy[1][q], w2 = cy[2][q], w3 = cy[3][q];
            const f32x2 a0 = __builtin_amdgcn_cvt_pk_f32_fp8((int)w0, false), a1 = __builtin_amdgcn_cvt_pk_f32_fp8((int)w0, true), b0 = __builtin_amdgcn_cvt_pk_f32_fp8((int)w1, false), b1 = __builtin_amdgcn_cvt_pk_f32_fp8((int)w1, true);
            const f32x2 c0 = __builtin_amdgcn_cvt_pk_f32_fp8((int)w2, false), c1 = __builtin_amdgcn_cvt_pk_f32_fp8((int)w2, true), d0 = __builtin_amdgcn_cvt_pk_f32_fp8((int)w3, false), d1 = __builtin_amdgcn_cvt_pk_f32_fp8((int)w3, true);
            const f32x4 g = *(const f32x4*)(gp + 4 * q);
            const float y0 = (a0.x + b0.x) + (c0.x + d0.x), y1 = (a0.y + b0.y) + (c0.y + d0.y), y2 = (a1.x + b1.x) + (c1.x + d1.x), y3 = (a1.y + b1.y) + (c1.y + d1.y);
            const float t0 = xv[4 * q] + g.x * y0, t1 = xv[4 * q + 1] + g.y * y1, t2 = xv[4 * q + 2] + g.z * y2, t3 = xv[4 * q + 3] + g.w * y3;
            v[4 * q] = t0; v[4 * q + 1] = t1; v[4 * q + 2] = t2; v[4 * q + 3] = t3; s += (t0 * t0 + t1 * t1) + (t2 * t2 + t3 * t3);
        }
        const float rs = rsqrtf(wave_sum(s) * (1.f / DM) + EPS);
        LAS unsigned char* stg = lds + wave * 4096;
        const int l2 = lane_id();
#pragma unroll
        for (int q = 0; q < 4; ++q) { const f32x4 f = *(const f32x4*)(a.inp(I_FING) + 16 * l2 + 4 * q);
            *(LAS f32x4*)(stg + l2 * 64 + ((q ^ ((l2 >> 2) & 3)) << 4)) = (f32x4){v[4 * q] * rs * f.x, v[4 * q + 1] * rs * f.y, v[4 * q + 2] * rs * f.z, v[4 * q + 3] * rs * f.w}; }
        f32x4* o = (f32x4*)(a.outp() + (size_t)m * DM) + l2;
#pragma unroll
        for (int i = 0; i < 4; ++i) { const int ls = 16 * i + (l2 >> 2);
            o[64 * i] = *(const LAS f32x4*)(stg + ls * 64 + (((l2 & 3) ^ ((ls >> 2) & 3)) << 4)); }
#pragma unroll
        for (int j = 0; j < 2; ++j) cx[j] = nx[j];
#pragma unroll
        for (int j = 0; j < 4; ++j) cy[j] = ny[j];
    }
#undef P8_LOAD
}

__device__ __forceinline__ void glds16(const void* gsrc, unsigned lds_dst) { unsigned keep;
    asm volatile("s_mov_b32 %0, m0\n\ts_mov_b32 m0, %2\n\ts_nop 0\n\tglobal_load_lds_dwordx4 %1, off\n\ts_mov_b32 m0, %0" : "=&s"(keep) : "v"(gsrc), "s"(lds_dst) : "memory"); }
__device__ __forceinline__ unsigned lds_addr(const LAS void* p) { return (unsigned)__builtin_amdgcn_readfirstlane((int)(unsigned)(unsigned long long)p); }

namespace pg8 {
#define PG8_LAS __attribute__((address_space(3)))
typedef short bf16x8 __attribute__((ext_vector_type(8)));
typedef int v4i __attribute__((ext_vector_type(4)));
typedef int v8i __attribute__((ext_vector_type(8)));
constexpr int BM = 256, BK = 64, HALF = 128, HTB = HALF * BK * 2, STAGE_BYTES = 8 * HTB, NXCD = 8, WGM = 8;
__host__ __device__ __forceinline__ int lds_byte(int r, int c) { const int st = (r >> 4) * 2 + (c >> 5), rr = r & 15, cc = c & 31, ob = rr * 64 + cc * 2; return st * 1024 + (ob ^ (((ob >> 9) & 1) << 5)); }
__host__ __device__ __forceinline__ void stage_rc(int b, int& R, int& C) { const int st = b / 1024, sb = b % 1024, swz = sb ^ (((sb >> 9) & 1) << 5); R = (st >> 1) * 16 + swz / 64; C = (st & 1) * 32 + (swz % 64) / 2; }
__host__ __device__ __forceinline__ int perm32(int rho) { const int n = rho >> 4, i = rho & 15; return 8 * (i >> 2) + 4 * n + (i & 3); }
typedef __bf16 hwbf16x2 __attribute__((ext_vector_type(2)));
typedef float f32x2v __attribute__((ext_vector_type(2)));
__device__ __forceinline__ unsigned cvt_pk_bf16(float lo, float hi) { const hwbf16x2 r = __builtin_convertvector((f32x2v){lo, hi}, hwbf16x2); return __builtin_bit_cast(unsigned, r); }

struct Unit { int pm, pn, e, nrows, slot; };

template <class Epi, class Sched, bool ALIGN_EPI>
__device__ __forceinline__ void gemm_phase(PG8_LAS unsigned char* lds, const void* Abase, unsigned Abytes, const void* Bbase, unsigned Bbytes, const int RB  ,
                                           const Sched& S, const Epi& E, const int wid) {
    const int lane = lane_id(), tid = wid * 64 + lane, wr = wid >> 2, wc = wid & 3, fr = lane & 15, fq = lane >> 4;
    const int nt = RB / 128;
    int R0, C0; stage_rc(tid * 16, R0, C0);
    const unsigned cb2 = (unsigned)C0 * 2u;
    const unsigned voffB = (unsigned)((Epi::PERM ? ((R0 & ~31) + perm32(R0 & 31)) : R0) * RB) + cb2;
    const __amdgpu_buffer_rsrc_t rsA = __builtin_amdgcn_make_buffer_rsrc((void*)Abase, 0, Abytes, 0x00020000);
    const __amdgpu_buffer_rsrc_t rsB = __builtin_amdgcn_make_buffer_rsrc((void*)Bbase, 0, Bbytes, 0x00020000);
    const unsigned hstep = (unsigned)HALF * RB;
    const unsigned ldsw = (unsigned)wid * 1024u;
    const int aoff = lds_byte(wr * 64 + fr, fq * 8), boff = lds_byte(wc * 32 + fr, fq * 8);
#define PG8_SA(b, h) (((b) * 2 + (h)) * HTB)
#define PG8_SB(b, h) ((4 + (b) * 2 + (h)) * HTB)
#define PG8_STAGE_B(bufoff, soff) do { _Pragma("unroll") for (int _i = 0; _i < 2; ++_i) \
        __builtin_amdgcn_raw_ptr_buffer_load_lds(rsB, (PG8_LAS void*)(lds + (bufoff) + ldsw + _i * 8192), 16, voffB, (soff) + (unsigned)(_i * 64 * RB), 0, 0); } while (0)
#define PG8_STAGE_A(bufoff, un, h, soff) do { _Pragma("unroll") for (int _i = 0; _i < 2; ++_i) \
        __builtin_amdgcn_raw_ptr_buffer_load_lds(rsA, (PG8_LAS void*)(lds + (bufoff) + ldsw + _i * 8192), 16, S.arow_off((un), (h) * HALF + R0 + 64 * _i) + cb2, (soff), 0, 0); } while (0)
#define PG8_LDA(dst, b, h) do { _Pragma("unroll") for (int m = 0; m < 4; ++m) _Pragma("unroll") for (int k = 0; k < 2; ++k) dst[m][k] = *(const PG8_LAS bf16x8*)(lds + PG8_SA(b, h) + aoff + m * 2048 + k * 1024); } while (0)
#define PG8_LDB(dst, b, h) do { _Pragma("unroll") for (int n = 0; n < 2; ++n) _Pragma("unroll") for (int k = 0; k < 2; ++k) dst[n][k] = *(const PG8_LAS bf16x8*)(lds + PG8_SB(b, h) + boff + n * 2048 + k * 1024); } while (0)
#define PG8_MMA(ai, bj, At, Bt) do { __builtin_amdgcn_s_setprio(1); _Pragma("unroll") for (int m = 0; m < 4; ++m) _Pragma("unroll") for (int n = 0; n < 2; ++n) _Pragma("unroll") for (int k = 0; k < 2; ++k) \
        acc[ai][bj][m][n] = __builtin_amdgcn_mfma_f32_16x16x32_bf16(Bt[n][k], At[m][k], acc[ai][bj][m][n], 0, 0, 0); __builtin_amdgcn_s_setprio(0); } while (0)
#define PG8_LDA8(dst, b, h) do { _Pragma("unroll") for (int m = 0; m < 4; ++m) { const v4i lo_ = *(const PG8_LAS v4i*)(lds + PG8_SA(b, h) + aoff + m * 2048), hi_ = *(const PG8_LAS v4i*)(lds + PG8_SA(b, h) + aoff + m * 2048 + 1024); \
        dst[m] = __builtin_shufflevector(lo_, hi_, 0, 1, 2, 3, 4, 5, 6, 7); } } while (0)
#define PG8_LDB8(dst, b, h) do { _Pragma("unroll") for (int n = 0; n < 2; ++n) { const v4i lo_ = *(const PG8_LAS v4i*)(lds + PG8_SB(b, h) + boff + n * 2048), hi_ = *(const PG8_LAS v4i*)(lds + PG8_SB(b, h) + boff + n * 2048 + 1024); \
        dst[n] = __builtin_shufflevector(lo_, hi_, 0, 1, 2, 3, 4, 5, 6, 7); } } while (0)
#define PG8_MMA8(ai, bj, A8_, B8_) do { __builtin_amdgcn_s_setprio(1); _Pragma("unroll") for (int m = 0; m < 4; ++m) _Pragma("unroll") for (int n = 0; n < 2; ++n) \
        acc[ai][bj][m][n] = __builtin_amdgcn_mfma_scale_f32_16x16x128_f8f6f4(B8_[n], A8_[m], acc[ai][bj][m][n], 0, 0, 0, 0, 0, 0);     __builtin_amdgcn_s_setprio(0); } while (0)
#define PG8_XLDA(b, h) do { if constexpr (Epi::FP8) PG8_LDA8(A8, b, h); else PG8_LDA(At, b, h); } while (0)
#define PG8_XLDB0(b, h) do { if constexpr (Epi::FP8) PG8_LDB8(B08, b, h); else PG8_LDB(B0, b, h); } while (0)
#define PG8_XLDB1(b, h) do { if constexpr (Epi::FP8) PG8_LDB8(B18, b, h); else PG8_LDB(B1, b, h); } while (0)
#define PG8_XMM0(ai, bj) do { if constexpr (Epi::FP8) PG8_MMA8(ai, bj, A8, B08); else PG8_MMA(ai, bj, At, B0); } while (0)
#define PG8_XMM1(ai, bj) do { if constexpr (Epi::FP8) PG8_MMA8(ai, bj, A8, B18); else PG8_MMA(ai, bj, At, B1); } while (0)
#define PG8_WAIT_V(n) asm volatile("s_waitcnt vmcnt(" #n ")" ::: "memory")
#define PG8_WAIT_L(n) asm volatile("s_waitcnt lgkmcnt(" #n ")" ::: "memory")
#define PG8_BAR __builtin_amdgcn_s_barrier()
#define PG8_SCHED __builtin_amdgcn_sched_barrier(0)
    Unit cur, nxt; int ui = 0;
    if (!S.next(0, cur)) return;
    f32x4 acc[2][2][4][2];
#pragma unroll
    for (int a = 0; a < 2; ++a)
#pragma unroll
        for (int b = 0; b < 2; ++b)
#pragma unroll
            for (int m = 0; m < 4; ++m)
#pragma unroll
                for (int n = 0; n < 2; ++n) acc[a][b][m][n] = (f32x4){0.f, 0.f, 0.f, 0.f};
    bf16x8 At[4][2], B0[2][2], B1[2][2];
    v8i A8[4], B08[2], B18[2];
    unsigned cBo = S.boff(cur);
    PG8_STAGE_B(PG8_SB(0, 0), cBo); PG8_STAGE_B(PG8_SB(0, 1), cBo + hstep); PG8_STAGE_A(PG8_SA(0, 0), cur, 0, 0u); PG8_STAGE_A(PG8_SA(0, 1), cur, 1, 0u);
    if (wr == 1) PG8_BAR;
    PG8_WAIT_V(2); PG8_BAR;
    PG8_STAGE_B(PG8_SB(1, 0), cBo + 128u); PG8_STAGE_A(PG8_SA(1, 0), cur, 0, 128u); PG8_STAGE_B(PG8_SB(1, 1), cBo + hstep + 128u);
    PG8_WAIT_V(6); PG8_BAR;
    for (;;) {
        if constexpr (Epi::BIAS) E.prefetch(cur, ui, wid);
        const bool has_next = S.next(ui + 1, nxt);
        const unsigned nBo = has_next ? S.boff(nxt) : cBo;
        for (int th = 0; th < (Epi::HAS_MID ? 2 : 1); ++th) {
        if constexpr (Epi::HAS_MID) { if (th == 1) E.mid(acc, ui, wr, lane_id() & 15); }
        const int tbeg = Epi::HAS_MID ? th * (nt / 2) : 0, tend = Epi::HAS_MID ? (th + 1) * (nt / 2) : nt;
#pragma unroll 1
        for (int t = tbeg; t < tend; t += 2) {
            const bool last = (t == nt - 2);
            const unsigned k1 = (unsigned)(t + 1) * 128u;
            const unsigned k2 = last ? 0u : (unsigned)(t + 2) * 128u;
            const unsigned k3 = k2 + 128u;
            const unsigned b2 = (last ? nBo : cBo) + k2, b3 = b2 + 128u;
            Unit u2 = cur; if (last && has_next) u2 = nxt;
            PG8_XLDB0(0, 0); PG8_XLDB1(0, 1); PG8_SCHED; PG8_XLDA(0, 0); PG8_STAGE_A(PG8_SA(1, 1), cur, 1, k1);
            PG8_WAIT_V(8); PG8_WAIT_L(0); PG8_BAR; PG8_XMM0(0, 0); PG8_XMM1(0, 1); PG8_BAR; PG8_SCHED;
            PG8_XLDA(0, 1); PG8_STAGE_B(PG8_SB(0, 0), b2); PG8_STAGE_B(PG8_SB(0, 1), b2 + hstep); PG8_STAGE_A(PG8_SA(0, 0), u2, 0, k2);
            PG8_WAIT_V(8); PG8_WAIT_L(0); PG8_BAR; PG8_XMM0(1, 0); PG8_XMM1(1, 1); PG8_BAR; PG8_SCHED;
            PG8_XLDB0(1, 0); PG8_XLDB1(1, 1); PG8_SCHED; PG8_XLDA(1, 0); PG8_STAGE_A(PG8_SA(0, 1), u2, 1, k2);
            PG8_WAIT_V(8); PG8_WAIT_L(0); PG8_BAR; PG8_XMM0(0, 0); PG8_XMM1(0, 1); PG8_BAR; PG8_SCHED;
            PG8_XLDA(1, 1); PG8_STAGE_B(PG8_SB(1, 0), b3); PG8_STAGE_B(PG8_SB(1, 1), b3 + hstep); PG8_STAGE_A(PG8_SA(1, 0), u2, 0, k3);
            PG8_WAIT_V(8); PG8_WAIT_L(0); PG8_BAR; PG8_XMM0(1, 0); PG8_XMM1(1, 1); PG8_BAR; PG8_SCHED;
        }
        }
        if constexpr (ALIGN_EPI) { if (wr == 0) PG8_BAR; }
        { const int l2 = lane_id(); E(acc, cur, ui, wr, wc, l2 & 15, l2 >> 4); }
        if (!has_next) break;
#pragma unroll
        for (int a = 0; a < 2; ++a)
#pragma unroll
            for (int b = 0; b < 2; ++b)
#pragma unroll
                for (int m = 0; m < 4; ++m)
#pragma unroll
                    for (int n = 0; n < 2; ++n) acc[a][b][m][n] = (f32x4){0.f, 0.f, 0.f, 0.f};
        cur = nxt; cBo = nBo; ++ui;
        if constexpr (ALIGN_EPI) { if (wr == 1) PG8_BAR; }
    }
    PG8_WAIT_V(0);
    if constexpr (!ALIGN_EPI) { if (wr == 0) PG8_BAR; }
    PG8_BAR;
#undef PG8_SA
#undef PG8_SB
#undef PG8_STAGE_A
#undef PG8_STAGE_B
#undef PG8_LDA
#undef PG8_LDB
#undef PG8_MMA
#undef PG8_MMA8
#undef PG8_LDA8
#undef PG8_LDB8
#undef PG8_XLDA
#undef PG8_XLDB0
#undef PG8_XLDB1
#undef PG8_XMM0
#undef PG8_XMM1
#undef PG8_WAIT_V
#undef PG8_WAIT_L
#undef PG8_BAR
#undef PG8_SCHED
}

struct StaticOrder {
    int nM, nN, nwg, G, c; const char* Bt; int K;
    __device__ void init(int M, int N, int G_, int c_, const void* Bt_, int K_) { nM = M / BM; nN = N / BM; nwg = nM * nN; G = G_; c = c_; Bt = (const char*)Bt_; K = K_; }
    __device__ __forceinline__ bool next(int i, Unit& u) const {
        const long L = (long)i * G + c; if (L >= nwg) return false;
        int wgid = (int)L; { const int q = nwg / NXCD, r = nwg % NXCD, xcd = wgid % NXCD, off = wgid / NXCD; wgid = (xcd < r ? xcd * (q + 1) : r * (q + 1) + (xcd - r) * q) + off; }
        const int nig = WGM * nN, gid = wgid / nig, fm = gid * WGM, gsz = (nM - fm) < WGM ? (nM - fm) : WGM;
        u.pm = fm + ((wgid % nig) % gsz); u.pn = (wgid % nig) / gsz; u.e = 0; u.nrows = 256; u.slot = i; return true;
    }
    __device__ __forceinline__ unsigned boff(const Unit& u) const { return (unsigned)u.pn * (unsigned)(BM * K * 2); }
    __device__ __forceinline__ unsigned arow_off(const Unit& u, int r) const { return (unsigned)(u.pm * BM + r) * (unsigned)(K * 2); }
};

struct EpiProj {
    static constexpr bool PERM = true, HAS_MID = false, FP8 = false, BIAS = false;
    bf16* O;
    __device__ __forceinline__ void operator()(const f32x4 (&acc)[2][2][4][2], const Unit& u, int ui, int wr, int wc, int fr, int fq) const {
        const int row0 = u.pm * BM + wr * 64 + fr; const int colt = u.pn * BM; const int t = colt / 512;
        bf16* base = O + (size_t)t * PROJ_STRIDE; const float sc = (t == 0) ? C2 : 1.f;
        const int col0 = (colt - t * 512) + wc * 32 + 8 * fq;
#pragma unroll
        for (int ai = 0; ai < 2; ++ai)
#pragma unroll
            for (int m = 0; m < 4; ++m) { bf16* rowp = base + (size_t)(row0 + ai * HALF + m * 16) * 512 + col0;
#pragma unroll
                for (int bj = 0; bj < 2; ++bj) { const f32x4 v0 = acc[ai][bj][m][0] * sc, v1 = acc[ai][bj][m][1] * sc;
                    u32x4 w; w.x = cvt_pk_bf16(v0[0], v0[1]); w.y = cvt_pk_bf16(v0[2], v0[3]); w.z = cvt_pk_bf16(v1[0], v1[1]); w.w = cvt_pk_bf16(v1[2], v1[3]);
                    *(u32x4*)(rowp + bj * HALF) = w; } }
    }
};

constexpr int MAXTILES = 544;
struct MoeTables { PG8_LAS int* te; PG8_LAS int* toff; PG8_LAS int* tn; PG8_LAS int* ent; PG8_LAS float* pw; int ntiles; };
__device__ __forceinline__ MoeTables moe_tables(PG8_LAS unsigned char* tab, const unsigned* cnt, int tid) {
    PG8_LAS int* tc = (PG8_LAS int*)tab;
    MoeTables T; T.te = tc + 64; T.toff = T.te + MAXTILES; T.tn = T.toff + MAXTILES; T.ent = T.tn + MAXTILES; T.pw = (PG8_LAS float*)(T.ent + 9 * 256);
    if (tid < 32) tc[tid] = (int)cnt[tid];
    __syncthreads();
    for (int t = tid; t < MAXTILES; t += 512) {
        int e = 0, accu = 0;
        for (; e < 32; ++e) { const int nt_e = (tc[e] + 255) >> 8; if (t < accu + nt_e) break; accu += nt_e; }
        if (e < 32) { const int off = (t - accu) * 256; T.te[t] = e; T.toff[t] = off; const int rem = tc[e] - off; T.tn[t] = rem < 256 ? rem : 256; }
    }
    if (tid == 0) { int s = 0; for (int e = 0; e < 32; ++e) s += (tc[e] + 255) >> 8; tc[32] = s; }
    __syncthreads();
    T.ntiles = __builtin_amdgcn_readfirstlane(tc[32]);
    return T;
}
struct MoeOrder {
    const char* Bt; int ncol, shift; MoeTables T; int xcd, iin, gx; int seq;
    __device__ __forceinline__ bool next(int i, Unit& u) const {
        int t, pn;
        if (seq) {
            const int nblk = gx * NXCD, nfull = T.ntiles / nblk, rem = T.ntiles - nfull * nblk;
            if (i < nfull * ncol) { t = (i / ncol) * nblk + xcd * gx + iin; pn = i % ncol; }
            else { const int r = (i - nfull * ncol) * nblk + iin * NXCD + xcd; if (r >= rem * ncol) return false; t = nfull * nblk + r / ncol; pn = r % ncol; }
        } else {
            const int rpx = gx / ncol, rl = iin / ncol; if (rl >= rpx) return false;
            t = (i * NXCD + xcd) * rpx + rl; if (t >= T.ntiles) return false; pn = iin % ncol;
        }
        u.e = __builtin_amdgcn_readfirstlane(T.te[t]); u.pm = __builtin_amdgcn_readfirstlane(T.toff[t]); u.nrows = __builtin_amdgcn_readfirstlane(T.tn[t]); u.pn = pn; u.slot = i; return true;
    }
    __device__ __forceinline__ void load_entries(const int* list, const float* pasg, int tid) const {
        const int w = tid >> 6, l = tid & 63; Unit u[3]; bool ok[3]; int en[3][4]; float pv[3][4];
#pragma unroll
        for (int j = 0; j < 3; ++j) { ok[j] = next(w + 8 * j, u[j]);
#pragma unroll
            for (int q = 0; q < 4; ++q) { const int r = 64 * q + l; en[j][q] = ok[j] ? list[u[j].e * NTOK + u[j].pm + (r < u[j].nrows ? r : 0)] : 0; } }
#pragma unroll
        for (int j = 0; j < 3; ++j)
#pragma unroll
            for (int q = 0; q < 4; ++q) pv[j][q] = (pasg && ok[j]) ? pasg[en[j][q]] : 0.f;
#pragma unroll
        for (int j = 0; j < 3; ++j) if (ok[j]) {
#pragma unroll
            for (int q = 0; q < 4; ++q) { T.ent[(w + 8 * j) * 256 + 64 * q + l] = en[j][q]; if (pasg) T.pw[(w + 8 * j) * 256 + 64 * q + l] = pv[j][q]; } }
        __syncthreads();
    }
    __device__ __forceinline__ unsigned boff(const Unit& u) const { return (unsigned)(u.e * ncol + u.pn) * (unsigned)(BM * 1024); }
    __device__ __forceinline__ unsigned arow_off(const Unit& u, int r) const { return (unsigned)(T.ent[u.slot * 256 + r] >> shift) * 1024u; }
};
struct EpiGU {
    static constexpr bool PERM = true, HAS_MID = false, FP8 = true, BIAS = true;
    PG8_LAS const int* ent; const float* bg; const float* bu; unsigned char* act; PG8_LAS const float* bl;
    __device__ __forceinline__ void prefetch(const Unit& u, int ui, int wid) const {
        if (wid == 0) { const int l = lane_id(); glds16((l < 32 ? bg : bu) + u.e * DE + u.pn * 128 + (l & 31) * 4, lds_addr(bl + (ui & 1) * 256)); }
    }
    __device__ __forceinline__ void operator()(const f32x4 (&acc)[2][2][4][2], const Unit& u, int ui, int wr, int wc, int fr, int fq) const {
        const int cb = u.pn * 128 + wc * 32 + 8 * fq;
        PG8_LAS const float* bp = bl + (ui & 1) * 256 + wc * 32 + 8 * fq;
        const f32x4 g0 = *(PG8_LAS const f32x4*)bp, g1 = *(PG8_LAS const f32x4*)(bp + 4), u0 = *(PG8_LAS const f32x4*)(bp + 128), u1 = *(PG8_LAS const f32x4*)(bp + 132);
        PG8_LAS const int* lp = ent + u.slot * 256;
        int en8[2][4];
#pragma unroll
        for (int ai = 0; ai < 2; ++ai)
#pragma unroll
            for (int m = 0; m < 4; ++m) en8[ai][m] = lp[ai * HALF + wr * 64 + m * 16 + fr];
        asm volatile("" : "+v"(en8[0][0]), "+v"(en8[0][1]), "+v"(en8[0][2]), "+v"(en8[0][3]), "+v"(en8[1][0]), "+v"(en8[1][1]), "+v"(en8[1][2]), "+v"(en8[1][3]));
#pragma unroll
        for (int ai = 0; ai < 2; ++ai)
#pragma unroll
            for (int m = 0; m < 4; ++m) { const int r = ai * HALF + wr * 64 + m * 16 + fr; const int entry = en8[ai][m];
                f32x4 gv[2] = {acc[ai][0][m][0] + g0, acc[ai][0][m][1] + g1}, uv[2] = {acc[ai][1][m][0] + u0, acc[ai][1][m][1] + u1}; float o[8];
#pragma unroll
                for (int n = 0; n < 2; ++n)
#pragma unroll
                    for (int i = 0; i < 4; ++i) { const float g = fminf(gv[n][i], 7.f), uu = fminf(fmaxf(uv[n][i], -7.f), 7.f);
                        o[4 * n + i] = (uu + 1.f) * g * __builtin_amdgcn_rcpf(1.f + __builtin_amdgcn_exp2f(-1.702f * 1.4426950408889634f * g)); }
                typedef unsigned u32x2 __attribute__((ext_vector_type(2)));
                const u32x2 w = {pk4_fp8_raw(o[0], o[1], o[2], o[3]), pk4_fp8_raw(o[4], o[5], o[6], o[7])};
                if (r < u.nrows) *(u32x2*)(act + (size_t)entry * DE + cb) = w; }
    }
};
struct EpiDown {
    static constexpr bool PERM = true, HAS_MID = false, FP8 = true, BIAS = true;
    PG8_LAS const int* ent; const float* bd; PG8_LAS const float* pw; unsigned char* yb; PG8_LAS const float* bl;
    __device__ __forceinline__ void prefetch(const Unit& u, int ui, int wid) const {
        if (wid == 0) { const int l = lane_id(); glds16(bd + u.e * DM + u.pn * BM + l * 4, lds_addr(bl + (ui & 1) * 256)); }
    }
    __device__ __forceinline__ void operator()(const f32x4 (&acc)[2][2][4][2], const Unit& u, int ui, int wr, int wc, int fr, int fq) const {
        const int cb = u.pn * BM + wc * 32 + 8 * fq;
        f32x4 bv[2][2];
#pragma unroll
        for (int bj = 0; bj < 2; ++bj)
#pragma unroll
            for (int n = 0; n < 2; ++n) bv[bj][n] = *(PG8_LAS const f32x4*)(bl + (ui & 1) * 256 + bj * HALF + wc * 32 + 8 * fq + 4 * n);
        PG8_LAS const int* lp = ent + u.slot * 256;
        int en8[2][4]; float p8[2][4];
#pragma unroll
        for (int ai = 0; ai < 2; ++ai)
#pragma unroll
            for (int m = 0; m < 4; ++m) { en8[ai][m] = lp[ai * HALF + wr * 64 + m * 16 + fr]; p8[ai][m] = pw[u.slot * 256 + ai * HALF + wr * 64 + m * 16 + fr]; }
        asm volatile("" : "+v"(en8[0][0]), "+v"(en8[0][1]), "+v"(en8[0][2]), "+v"(en8[0][3]), "+v"(en8[1][0]), "+v"(en8[1][1]), "+v"(en8[1][2]), "+v"(en8[1][3]));
        asm volatile("" : "+v"(p8[0][0]), "+v"(p8[0][1]), "+v"(p8[0][2]), "+v"(p8[0][3]), "+v"(p8[1][0]), "+v"(p8[1][1]), "+v"(p8[1][2]), "+v"(p8[1][3]));
#pragma unroll
        for (int ai = 0; ai < 2; ++ai)
#pragma unroll
            for (int m = 0; m < 4; ++m) { const int r = ai * HALF + wr * 64 + m * 16 + fr; const int entry = en8[ai][m]; const float p = p8[ai][m];
                unsigned char* rowp = yb + (size_t)entry * DM + cb;
#pragma unroll
                for (int bj = 0; bj < 2; ++bj) { const f32x4 v0 = (acc[ai][bj][m][0] + bv[bj][0]) * p, v1 = (acc[ai][bj][m][1] + bv[bj][1]) * p;
                    typedef unsigned u32x2 __attribute__((ext_vector_type(2)));
                    if (r < u.nrows) *(u32x2*)(rowp + bj * HALF) = (u32x2){pk4_fp8_m3(v0[0], v0[1], v0[2], v0[3]), pk4_fp8_m3(v1[0], v1[1], v1[2], v1[3])}; } }
    }
};
struct EpiOut {
    static constexpr bool PERM = true, HAS_MID = true, FP8 = false, BIAS = false;
    const float* x; const float* mod; bf16* x1b; float* ssx; PG8_LAS const float* rst;
    __device__ __forceinline__ void mid(f32x4 (&acc)[2][2][4][2], int ui, int wr, int fr) const {
#pragma unroll
        for (int ai = 0; ai < 2; ++ai)
#pragma unroll
            for (int m = 0; m < 4; ++m) { const int r = ai * HALF + wr * 64 + m * 16 + fr; const float ra = rst[(ui * 256 + r) * 2], rl = rst[(ui * 256 + r) * 2 + 1]; const float ratio = ra / rl;
#pragma unroll
                for (int bj = 0; bj < 2; ++bj)
#pragma unroll
                    for (int n = 0; n < 2; ++n) acc[ai][bj][m][n] = acc[ai][bj][m][n] * ratio; }
    }
    __device__ __forceinline__ void operator()(const f32x4 (&acc)[2][2][4][2], const Unit& u, int ui, int wr, int wc, int fr, int fq) const {
        const int b = (u.pm * BM) / SEQ; const float* gm = mod + b * 6144 + 2048;
        const int cb = u.pn * BM + wc * 32 + 8 * fq;
        f32x4 gv[2][2];
#pragma unroll
        for (int bj = 0; bj < 2; ++bj)
#pragma unroll
            for (int n = 0; n < 2; ++n) gv[bj][n] = *(const f32x4*)(gm + cb + bj * HALF + 4 * n);
#pragma unroll
        for (int ai = 0; ai < 2; ++ai)
#pragma unroll
            for (int m = 0; m < 4; ++m) { const int r = ai * HALF + wr * 64 + m * 16 + fr; const size_t grow = (size_t)u.pm * BM + r; const float rl = rst[(ui * 256 + r) * 2 + 1];
                float ss = 0.f;
#pragma unroll
                for (int bj = 0; bj < 2; ++bj) { const float* xp = x + grow * DM + cb + bj * HALF;
                    const f32x4 v0 = *(const f32x4*)xp + gv[bj][0] * (acc[ai][bj][m][0] * rl), v1 = *(const f32x4*)(xp + 4) + gv[bj][1] * (acc[ai][bj][m][1] * rl);
                    ss += (v0[0] * v0[0] + v0[1] * v0[1]) + (v0[2] * v0[2] + v0[3] * v0[3]) + (v1[0] * v1[0] + v1[1] * v1[1]) + (v1[2] * v1[2] + v1[3] * v1[3]);
                    u32x4 w; w.x = cvt_pk_bf16(v0[0], v0[1]); w.y = cvt_pk_bf16(v0[2], v0[3]); w.z = cvt_pk_bf16(v1[0], v1[1]); w.w = cvt_pk_bf16(v1[2], v1[3]);
                    *(u32x4*)(x1b + grow * DM + cb + bj * HALF) = w; }
                ss += __shfl_xor(ss, 16); ss += __shfl_xor(ss, 32);
                if (fq == 0) ssx[grow * 16 + u.pn * 4 + wc] = ss;
                asm volatile("" ::: "memory"); }
    }
};
}


__device__ __forceinline__ void p5_router(const Args& a, LAS unsigned char* lds, int tid, int lane, int wave, int G) {
    typedef short bf16x8 __attribute__((ext_vector_type(8)));
    LAS float* ab = (LAS float*)(lds + TAB_OFF);
    LAS float* lg = ab + 2048 + wave * 512;
    LAS unsigned* hist = (LAS unsigned*)(lds + TAB_OFF + 8192 + 16384);
    const int col = lane & 15, kq = lane >> 4;
    const bf16* x1b = (const bf16*)(a.wsp() + WS_X1B);
    u32x4 xv[32];
#define P5_LOADX(bt) do { const u32x4* xr_ = (const u32x4*)(x1b + (size_t)((bt) * 128 + wave * 16 + col) * DM) + kq; _Pragma("unroll") for (int i_ = 0; i_ < 32; ++i_) xv[i_] = xr_[4 * i_]; } while (0)
    if ((int)blockIdx.x < NTOK / 128) P5_LOADX((int)blockIdx.x);
    { const u32x4* wsrc = (const u32x4*)(a.wsp() + WS_WR);
      for (int i = tid; i < 2 * 32 * 128; i += 512) { const int hl = i >> 12, e = (i >> 7) & 31, c = i & 127;
          *(LAS u32x4*)(lds + hl * 65536 + e * 2048 + ((c ^ (e & 15)) << 4)) = wsrc[i]; } }
    const float* mod = (const float*)(a.wsp() + WS_MOD); const float* ssx = (const float*)(a.wsp() + WS_SSX);
    unsigned char* h2 = (unsigned char*)a.outp() + DO_H2;
    unsigned* cnt = (unsigned*)(a.wsp() + WS_CTL) + CW_CNT; int* list = (int*)(a.wsp() + WS_LIST); float* pasg = (float*)(a.wsp() + WS_PASG);
    int cur_b = -1;
    for (int batch = blockIdx.x; batch < NTOK / 128; batch += G) {
        const int b = (batch * 128) / SEQ;
        __syncthreads();
        if (b != cur_b) { for (int k = tid; k < 1024; k += 512) { ab[k] = a.inp(I_FFNG)[k] * (1.f + mod[b * 6144 + 4096 + k]); ab[1024 + k] = mod[b * 6144 + 3072 + k]; } cur_b = b; }
        if (tid < 64) hist[tid] = 0u;
        __syncthreads();
        const int tok = batch * 128 + wave * 16 + col;
        float rs2;
        { const f32x4 pp = *(const f32x4*)(ssx + (size_t)tok * 16 + 4 * kq); float s = (pp.x + pp.y) + (pp.z + pp.w); s += __shfl_xor(s, 16); s += __shfl_xor(s, 32); rs2 = rsqrtf(s * (1.f / 1024.f) + EPS); }
        typedef unsigned u32x2 __attribute__((ext_vector_type(2))); u32x2* hrow = (u32x2*)(h2 + (size_t)tok * DM) + kq;
        f32x4 acc0 = {0.f, 0.f, 0.f, 0.f}, acc1 = {0.f, 0.f, 0.f, 0.f};
        const LAS unsigned char* wb = lds + col * 2048;
#pragma unroll
        for (int kb = 0; kb < 32; kb += 8) {
#pragma unroll
            for (int i = 0; i < 8; ++i) { const int ks = kb + i;
                float xf[8]; unpack8(xv[ks], xf);
                const LAS f32x4* al = (const LAS f32x4*)(ab + 32 * ks + 8 * kq); const LAS f32x4* be = (const LAS f32x4*)(ab + 1024 + 32 * ks + 8 * kq);
                const f32x4 a0 = al[0], a1 = al[1], b0 = be[0], b1 = be[1];
                float h[8] = {xf[0] * rs2 * a0.x + b0.x, xf[1] * rs2 * a0.y + b0.y, xf[2] * rs2 * a0.z + b0.z, xf[3] * rs2 * a0.w + b0.w,
                              xf[4] * rs2 * a1.x + b1.x, xf[5] * rs2 * a1.y + b1.y, xf[6] * rs2 * a1.z + b1.z, xf[7] * rs2 * a1.w + b1.w};
                u32x4 hh, hl;
                hh.x = pg8::cvt_pk_bf16(h[0], h[1]); hh.y = pg8::cvt_pk_bf16(h[2], h[3]); hh.z = pg8::cvt_pk_bf16(h[4], h[5]); hh.w = pg8::cvt_pk_bf16(h[6], h[7]);
                float hf[8]; unpack8(hh, hf);
                hl.x = pg8::cvt_pk_bf16(h[0] - hf[0], h[1] - hf[1]); hl.y = pg8::cvt_pk_bf16(h[2] - hf[2], h[3] - hf[3]); hl.z = pg8::cvt_pk_bf16(h[4] - hf[4], h[5] - hf[5]); hl.w = pg8::cvt_pk_bf16(h[6] - hf[6], h[7] - hf[7]);
                hrow[4 * ks] = (u32x2){pk4_fp8_m3(h[0], h[1], h[2], h[3]), pk4_fp8_m3(h[4], h[5], h[6], h[7])};
                const int so = ((4 * ks + kq) ^ col) << 4;
                const bf16x8 bh0 = *(const LAS bf16x8*)(wb + so), bh1 = *(const LAS bf16x8*)(wb + 32768 + so), bl0 = *(const LAS bf16x8*)(wb + 65536 + so), bl1 = *(const LAS bf16x8*)(wb + 65536 + 32768 + so);
                const bf16x8 ah = __builtin_bit_cast(bf16x8, hh), alo = __builtin_bit_cast(bf16x8, hl);
                acc0 = __builtin_amdgcn_mfma_f32_16x16x32_bf16(ah, bh0, acc0, 0, 0, 0); acc1 = __builtin_amdgcn_mfma_f32_16x16x32_bf16(ah, bh1, acc1, 0, 0, 0);
                acc0 = __builtin_amdgcn_mfma_f32_16x16x32_bf16(ah, bl0, acc0, 0, 0, 0); acc1 = __builtin_amdgcn_mfma_f32_16x16x32_bf16(ah, bl1, acc1, 0, 0, 0);
                acc0 = __builtin_amdgcn_mfma_f32_16x16x32_bf16(alo, bh0, acc0, 0, 0, 0); acc1 = __builtin_amdgcn_mfma_f32_16x16x32_bf16(alo, bh1, acc1, 0, 0, 0);
            }
        }
        if (batch + G < NTOK / 128) P5_LOADX(batch + G);
        { const float rb0 = a.inp(I_RB)[col], rb1 = a.inp(I_RB)[16 + col];
#pragma unroll
          for (int r = 0; r < 4; ++r) { lg[(4 * kq + r) * 32 + col] = acc0[r] + rb0; lg[(4 * kq + r) * 32 + 16 + col] = acc1[r] + rb1; } }
        LDS_WAIT();
        int e0 = 0, e1 = 0, e2 = 0, e3 = 0; unsigned r0 = 0, r1 = 0, r2 = 0, r3 = 0; float p0 = 0.f, p1 = 0.f, p2 = 0.f, p3 = 0.f;
        if (lane < 16) {
            float v[32];
#pragma unroll
            for (int q = 0; q < 8; ++q) { const f32x4 t = *(const LAS f32x4*)(lg + lane * 32 + 4 * q); v[4 * q] = t.x; v[4 * q + 1] = t.y; v[4 * q + 2] = t.z; v[4 * q + 3] = t.w; }
            unsigned chosen = 0u; float tv[4]; int ti[4];
#pragma unroll
            for (int k = 0; k < 4; ++k) { float bv = -INFINITY; int bi = 0;
#pragma unroll
                for (int e = 0; e < 32; ++e) { const float c = ((chosen >> e) & 1u) ? -INFINITY : v[e]; if (c > bv) { bv = c; bi = e; } }
                tv[k] = bv; ti[k] = bi; chosen |= 1u << bi; }
            const float q1 = __expf(tv[1] - tv[0]), q2 = __expf(tv[2] - tv[0]), q3 = __expf(tv[3] - tv[0]), inv = 1.f / (1.f + q1 + q2 + q3);
            e0 = ti[0]; e1 = ti[1]; e2 = ti[2]; e3 = ti[3]; p0 = inv; p1 = q1 * inv; p2 = q2 * inv; p3 = q3 * inv;
            r0 = __hip_atomic_fetch_add(hist + e0, 1u, __ATOMIC_RELAXED, __HIP_MEMORY_SCOPE_WORKGROUP); r1 = __hip_atomic_fetch_add(hist + e1, 1u, __ATOMIC_RELAXED, __HIP_MEMORY_SCOPE_WORKGROUP);
            r2 = __hip_atomic_fetch_add(hist + e2, 1u, __ATOMIC_RELAXED, __HIP_MEMORY_SCOPE_WORKGROUP); r3 = __hip_atomic_fetch_add(hist + e3, 1u, __ATOMIC_RELAXED, __HIP_MEMORY_SCOPE_WORKGROUP);
        }
        __syncthreads();
        if (tid < 32) hist[32 + tid] = atomicAdd(&cnt[tid], hist[tid]);
        __syncthreads();
        if (lane < 16) { const int tk = batch * 128 + wave * 16 + lane;
            list[e0 * NTOK + hist[32 + e0] + r0] = tk * 4 + 0; list[e1 * NTOK + hist[32 + e1] + r1] = tk * 4 + 1; list[e2 * NTOK + hist[32 + e2] + r2] = tk * 4 + 2; list[e3 * NTOK + hist[32 + e3] + r3] = tk * 4 + 3;
            *(f32x4*)(pasg + (size_t)tk * 4) = (f32x4){p0, p1, p2, p3}; }
    }
}


namespace att {
typedef short bf16x8 __attribute__((ext_vector_type(8)));
typedef short s16x4 __attribute__((ext_vector_type(4)));
typedef float f32x16 __attribute__((ext_vector_type(16)));
constexpr int LDS_FLAG = 6 * 16384;
constexpr float ATT_THR = 32.f;
__device__ __forceinline__ int crow(int r, int hh) { return (r & 3) + 8 * (r >> 2) + 4 * hh; }
__device__ __forceinline__ bf16x8 pack8(const float* v) {
    u32x4 w; w.x = pg8::cvt_pk_bf16(v[0], v[1]); w.y = pg8::cvt_pk_bf16(v[2], v[3]); w.z = pg8::cvt_pk_bf16(v[4], v[5]); w.w = pg8::cvt_pk_bf16(v[6], v[7]); return __builtin_bit_cast(bf16x8, w);
}
__device__ __forceinline__ s16x4 vtr(const LAS unsigned char* p) { typedef short v4i16_t __attribute__((ext_vector_type(4))); return __builtin_bit_cast(s16x4, __builtin_amdgcn_ds_read_tr16_b64_v4i16((LAS v4i16_t*)p)); }
typedef float f32x2 __attribute__((ext_vector_type(2)));
__device__ __forceinline__ float clamp_s(float x) { return __builtin_amdgcn_fmed3f(x, -1e30f, 115.f); }
__device__ __forceinline__ void softplus16(const f32x16& sv, float* L) {
#pragma unroll
    for (int r = 0; r < 16; r += 2) { const f32x2 t = (f32x2){__builtin_amdgcn_exp2f(sv[r]), __builtin_amdgcn_exp2f(sv[r + 1])} + (f32x2){1.f, 1.f}; L[r] = __builtin_amdgcn_logf(t.x); L[r + 1] = __builtin_amdgcn_logf(t.y); }
}
__device__ __forceinline__ void exp2c16(const f32x16& iv, float c, float* w) {
#pragma unroll
    for (int r = 0; r < 16; r += 2) { const f32x2 t = (f32x2){iv[r], iv[r + 1]} + (f32x2){c, c}; w[r] = __builtin_amdgcn_exp2f(t.x); w[r + 1] = __builtin_amdgcn_exp2f(t.y); }
}
template <bool DIAG>
__device__ __forceinline__ void block32(f32x16& o0, f32x16& o1, float& c, const bf16x8 (&qf)[4], const bf16x8 (&Mf)[2], const LAS unsigned char* Kb, const LAS unsigned char* Vb, int kbl, int r32, int hh, int lane) {
    f32x16 st = {0.f, 0.f, 0.f, 0.f, 0.f, 0.f, 0.f, 0.f, 0.f, 0.f, 0.f, 0.f, 0.f, 0.f, 0.f, 0.f};
#pragma unroll
    for (int ks = 0; ks < 4; ++ks) { const bf16x8 kf = *(const LAS bf16x8*)(Kb + (2 * ks + hh) * 1024 + (32 * kbl + r32) * 16); st = __builtin_amdgcn_mfma_f32_32x32x16_bf16(kf, qf[ks], st, 0, 0, 0); }
    float w[16], tot;
    if (DIAG) {
        float u[16], L[16];
#pragma unroll
        for (int r = 0; r < 16; ++r) { float uu = __builtin_amdgcn_exp2f(clamp_s(st[r])); if (crow(r, hh) >= r32) uu = 0.f; u[r] = uu; L[r] = __builtin_amdgcn_logf(1.f + uu); }
        const bf16x8 lp0 = pack8(L), lp1 = pack8(L + 8);
        f32x16 inc = {0.f, 0.f, 0.f, 0.f, 0.f, 0.f, 0.f, 0.f, 0.f, 0.f, 0.f, 0.f, 0.f, 0.f, 0.f, 0.f};
        inc = __builtin_amdgcn_mfma_f32_32x32x16_bf16(Mf[0], lp0, inc, 0, 0, 0); inc = __builtin_amdgcn_mfma_f32_32x32x16_bf16(Mf[1], lp1, inc, 0, 0, 0);
        { const unsigned t0 = __float_as_uint(inc[0]); auto rr = __builtin_amdgcn_permlane32_swap(t0, t0, false, false); tot = __uint_as_float(rr[0]); }
#pragma unroll
        for (int r = 0; r < 16; ++r) w[r] = u[r] * __builtin_amdgcn_exp2f(inc[r] + c);
    } else {
        float L[16];
#pragma unroll
        for (int r = 0; r < 16; ++r) st[r] = clamp_s(st[r]);
        softplus16(st, L);
        const float s0 = st[0];
        const bf16x8 lp0 = pack8(L), lp1 = pack8(L + 8);
        f32x16 inc = __builtin_amdgcn_mfma_f32_32x32x16_bf16(Mf[0], lp0, st, 0, 0, 0); inc = __builtin_amdgcn_mfma_f32_32x32x16_bf16(Mf[1], lp1, inc, 0, 0, 0);
        { const unsigned t0 = __float_as_uint(inc[0] - s0); auto rr = __builtin_amdgcn_permlane32_swap(t0, t0, false, false); tot = __uint_as_float(rr[0]); }
        exp2c16(inc, c, w);
    }
    c += tot;
    const bf16x8 pw0 = pack8(w), pw1 = pack8(w + 8);
    const LAS unsigned char* vp = Vb + ((lane >> 4) & 1) * 32 + (lane & 3) * 8 + (4 * hh + ((lane & 15) >> 2)) * 64 + (2 * kbl) * 1024;
#pragma unroll
    for (int db = 0; db < 2; ++db) {
        const s16x4 l0 = vtr(vp + db * 4096), h0 = vtr(vp + db * 4096 + 512), l1 = vtr(vp + db * 4096 + 1024), h1 = vtr(vp + db * 4096 + 1024 + 512);
        const bf16x8 v0 = (bf16x8){l0[0], l0[1], l0[2], l0[3], h0[0], h0[1], h0[2], h0[3]}, v1 = (bf16x8){l1[0], l1[1], l1[2], l1[3], h1[0], h1[1], h1[2], h1[3]};
        if (db == 0) { o0 = __builtin_amdgcn_mfma_f32_32x32x16_bf16(v0, pw0, o0, 0, 0, 0); o0 = __builtin_amdgcn_mfma_f32_32x32x16_bf16(v1, pw1, o0, 0, 0, 0); }
        else         { o1 = __builtin_amdgcn_mfma_f32_32x32x16_bf16(v0, pw0, o1, 0, 0, 0); o1 = __builtin_amdgcn_mfma_f32_32x32x16_bf16(v1, pw1, o1, 0, 0, 0); }
    }
}
__device__ __forceinline__ void tile64(f32x16& o0, f32x16& o1, float& c, const bf16x8 (&qf)[4], const bf16x8 (&Mf)[2], const LAS unsigned char* Kb, const LAS unsigned char* Vb, int r32, int hh, int lane) {
    const f32x16 z16 = {0.f, 0.f, 0.f, 0.f, 0.f, 0.f, 0.f, 0.f, 0.f, 0.f, 0.f, 0.f, 0.f, 0.f, 0.f, 0.f};
    bf16x8 kf[8];
#pragma unroll
    for (int q = 0; q < 8; ++q) kf[q] = *(const LAS bf16x8*)(Kb + (2 * (q & 3) + hh) * 1024 + (32 * (q >> 2) + r32) * 16);
    asm volatile("" : "+v"(kf[0]), "+v"(kf[1]), "+v"(kf[2]), "+v"(kf[3]), "+v"(kf[4]), "+v"(kf[5]), "+v"(kf[6]), "+v"(kf[7]));
    f32x16 sl = z16, su = z16;
#pragma unroll
    for (int ks = 0; ks < 4; ++ks) { su = __builtin_amdgcn_mfma_f32_32x32x16_bf16(kf[4 + ks], qf[ks], su, 0, 0, 0); sl = __builtin_amdgcn_mfma_f32_32x32x16_bf16(kf[ks], qf[ks], sl, 0, 0, 0); }
    float L[16];
#pragma unroll
    for (int r = 0; r < 16; ++r) su[r] = clamp_s(su[r]);
    softplus16(su, L);
    const float su0 = su[0];
    const bf16x8 lu0 = pack8(L), lu1 = pack8(L + 8);
    f32x16 iu = __builtin_amdgcn_mfma_f32_32x32x16_bf16(Mf[0], lu0, su, 0, 0, 0); iu = __builtin_amdgcn_mfma_f32_32x32x16_bf16(Mf[1], lu1, iu, 0, 0, 0);
#pragma unroll
    for (int r = 0; r < 16; ++r) sl[r] = clamp_s(sl[r]);
    softplus16(sl, L);
    const float sl0 = sl[0];
    const bf16x8 ll0 = pack8(L), ll1 = pack8(L + 8);
    f32x16 il = __builtin_amdgcn_mfma_f32_32x32x16_bf16(Mf[0], ll0, sl, 0, 0, 0); il = __builtin_amdgcn_mfma_f32_32x32x16_bf16(Mf[1], ll1, il, 0, 0, 0);
    const LAS unsigned char* vp = Vb + ((lane >> 4) & 1) * 32 + (lane & 3) * 8 + (4 * hh + ((lane & 15) >> 2)) * 64;
    s16x4 vl[2][4], vh[2][4];
#pragma unroll
    for (int db = 0; db < 2; ++db)
#pragma unroll
        for (int g = 0; g < 4; ++g) { vl[db][g] = vtr(vp + db * 4096 + g * 1024); vh[db][g] = vtr(vp + db * 4096 + g * 1024 + 512); }
    float totu, totl;
    { const unsigned t0 = __float_as_uint(iu[0] - su0); auto rr = __builtin_amdgcn_permlane32_swap(t0, t0, false, false); totu = __uint_as_float(rr[0]); }
    { const unsigned t0 = __float_as_uint(il[0] - sl0); auto rr = __builtin_amdgcn_permlane32_swap(t0, t0, false, false); totl = __uint_as_float(rr[0]); }
    float w[16];
    exp2c16(iu, c, w);
    const bf16x8 pu0 = pack8(w), pu1 = pack8(w + 8);
    const float c1 = c + totu;
    exp2c16(il, c1, w);
    const bf16x8 pl0 = pack8(w), pl1 = pack8(w + 8);
    c = c1 + totl;
#define ATT_VF(db, g) (bf16x8){vl[db][g][0], vl[db][g][1], vl[db][g][2], vl[db][g][3], vh[db][g][0], vh[db][g][1], vh[db][g][2], vh[db][g][3]}
    o0 = __builtin_amdgcn_mfma_f32_32x32x16_bf16(ATT_VF(0, 2), pu0, o0, 0, 0, 0); o1 = __builtin_amdgcn_mfma_f32_32x32x16_bf16(ATT_VF(1, 2), pu0, o1, 0, 0, 0);
    o0 = __builtin_amdgcn_mfma_f32_32x32x16_bf16(ATT_VF(0, 3), pu1, o0, 0, 0, 0); o1 = __builtin_amdgcn_mfma_f32_32x32x16_bf16(ATT_VF(1, 3), pu1, o1, 0, 0, 0);
    o0 = __builtin_amdgcn_mfma_f32_32x32x16_bf16(ATT_VF(0, 0), pl0, o0, 0, 0, 0); o1 = __builtin_amdgcn_mfma_f32_32x32x16_bf16(ATT_VF(1, 0), pl0, o1, 0, 0, 0);
    o0 = __builtin_amdgcn_mfma_f32_32x32x16_bf16(ATT_VF(0, 1), pl1, o0, 0, 0, 0); o1 = __builtin_amdgcn_mfma_f32_32x32x16_bf16(ATT_VF(1, 1), pl1, o1, 0, 0, 0);
#undef ATT_VF
}
constexpr int NS = 6;
__device__ __forceinline__ void attn_unit(const bf16* Q, const bf16* K, const bf16* V, bf16* Y, float* ssa, LAS unsigned char* lds, int b, int h, int qt, int wave, int lane) {
    const int r32 = lane & 31, hh = lane >> 5;
    const size_t rowbase = (size_t)b * SEQ; const int tq0 = 256 * qt + 32 * wave;
    const bf16* Kh = K + rowbase * 512 + h * 64; const bf16* Vh = V + rowbase * 512 + h * 64;
    const bf16* ksrc = Kh + (size_t)lane * 512 + wave * 8;
    const bf16* vsrc = Vh + (size_t)(16 * (wave & 3) + (lane >> 2)) * 512 + (wave >> 2) * 32 + (lane & 3) * 8;
#define ATT_STAGE(kt, slot) do { glds16(ksrc + (size_t)(kt) * 64 * 512, lds_addr(lds + (slot) * 16384 + wave * 1024)); \
                                 glds16(vsrc + (size_t)(kt) * 64 * 512, lds_addr(lds + (slot) * 16384 + 8192 + wave * 1024)); } while (0)
    const int kt_hi = 4 * qt + 3;
    bf16x8 qf[4];
    { const bf16* qp = Q + (rowbase + tq0 + r32) * 512 + h * 64 + 8 * hh;
#pragma unroll
      for (int ks = 0; ks < 4; ++ks) qf[ks] = *(const bf16x8*)(qp + 16 * ks); }
#pragma unroll
    for (int j = 0; j < 5; ++j) if (kt_hi - j >= 0) ATT_STAGE(kt_hi - j, j);
    bf16x8 Mf[2];
#pragma unroll
    for (int ks = 0; ks < 2; ++ks)
#pragma unroll
        for (int j = 0; j < 8; ++j) Mf[ks][j] = ((16 * ks + 8 * (j >> 2) + 4 * hh + (j & 3)) >= r32) ? (short)0xBF80 : (short)0;
    f32x16 o0 = {0.f, 0.f, 0.f, 0.f, 0.f, 0.f, 0.f, 0.f, 0.f, 0.f, 0.f, 0.f, 0.f, 0.f, 0.f, 0.f}, o1 = o0;
    float c = 0.f; bool done = false;
    LAS unsigned* flags = (LAS unsigned*)(lds + LDS_FLAG);
    asm volatile("" :: "v"(qf[0]), "v"(qf[1]), "v"(qf[2]), "v"(qf[3]));
#define ATT_TILE_P(kt, Kb_, Vb_) do { const LAS unsigned char* Kb = (Kb_); const LAS unsigned char* Vb = (Vb_); \
            if (64 * (kt) + 32 < tq0) tile64(o0, o1, c, qf, Mf, Kb, Vb, r32, hh, lane);        \
            else { _Pragma("unroll") for (int kbl = 1; kbl >= 0; --kbl) { const int s0 = 64 * (kt) + 32 * kbl; \
                    if (s0 < tq0) block32<false>(o0, o1, c, qf, Mf, Kb, Vb, kbl, r32, hh, lane); \
                    else if (s0 == tq0) block32<true>(o0, o1, c, qf, Mf, Kb, Vb, kbl, r32, hh, lane); } } \
            done = __all(c < -ATT_THR) != 0; } while (0)
    int kt = 4 * qt + (wave >> 1);
    int sw = 3 - (wave >> 1);
    int sp = 5, fs = 0, fprev = 2;
#pragma unroll 1
    for (int s = 0; ; ++s) {
        if (s > 0 && kt_hi - (s + 4) >= 0) asm volatile("s_waitcnt vmcnt(2) lgkmcnt(0)\n\ts_barrier" ::: "memory");
        else asm volatile("s_waitcnt vmcnt(0) lgkmcnt(0)\n\ts_barrier" ::: "memory");
        if (s > 0) { const u32x4 f0 = *(const LAS u32x4*)(flags + fprev * 8), f1 = *(const LAS u32x4*)(flags + fprev * 8 + 4);
            if ((f0.x & f0.y & f0.z & f0.w & f1.x & f1.y & f1.z & f1.w) != 0u) break; }
        if (kt_hi - (s + 5) >= 0) ATT_STAGE(kt_hi - (s + 5), sp);
        if (!done && kt >= 0) ATT_TILE_P(kt, lds + sw * 16384, lds + sw * 16384 + 8192);
        if (lane == 0) flags[fs * 8 + wave] = (done || kt <= 0) ? 1u : 0u;
        --kt; sw = (sw == NS - 1) ? 0 : sw + 1; sp = (sp == NS - 1) ? 0 : sp + 1; fprev = fs; fs = (fs == 2) ? 0 : fs + 1;
    }
#undef ATT_TILE_P
    asm volatile("s_waitcnt vmcnt(0)" ::: "memory");
    float ss = 0.f;
    LAS unsigned char* stg = lds + 100352 + wave * 4608;
    { LAS unsigned char* wp = stg + r32 * 144 + 8 * hh;
#pragma unroll
      for (int g = 0; g < 4; ++g) {
        const float a0 = o0[4 * g], a1 = o0[4 * g + 1], a2 = o0[4 * g + 2], a3 = o0[4 * g + 3], b0 = o1[4 * g], b1 = o1[4 * g + 1], b2 = o1[4 * g + 2], b3 = o1[4 * g + 3];
        ss += (a0 * a0 + a1 * a1) + (a2 * a2 + a3 * a3) + (b0 * b0 + b1 * b1) + (b2 * b2 + b3 * b3);
        *(LAS unsigned long long*)(wp + 16 * g) = (unsigned long long)pg8::cvt_pk_bf16(a0, a1) | ((unsigned long long)pg8::cvt_pk_bf16(a2, a3) << 32);
        *(LAS unsigned long long*)(wp + 64 + 16 * g) = (unsigned long long)pg8::cvt_pk_bf16(b0, b1) | ((unsigned long long)pg8::cvt_pk_bf16(b2, b3) << 32);
      } }
    { bf16* yp = Y + (rowbase + tq0 + (lane >> 3)) * DM + h * 64 + (lane & 7) * 8;
#pragma unroll
      for (int i = 0; i < 4; ++i) { const u32x4 v = *(const LAS u32x4*)(stg + (8 * i + (lane >> 3)) * 144 + (lane & 7) * 16); *(u32x4*)(yp + (size_t)(8 * i) * DM) = v; } }
    { const unsigned t0 = __float_as_uint(ss); auto rr = __builtin_amdgcn_permlane32_swap(t0, t0, false, false); ss = __uint_as_float(rr[0]) + __uint_as_float(rr[1]); }
    if (hh == 0) ssa[(rowbase + tq0 + r32) * 8 + h] = ss;
#undef ATT_STAGE
}
__device__ __forceinline__ void attn_phase(const Args& a, LAS unsigned char* lds, int wave, int lane, int G, int bx) {
    const bf16* Q = (const bf16*)(a.wsp() + WS_PROJ); const bf16* K = Q + PROJ_STRIDE; const bf16* V = K + PROJ_STRIDE;
    bf16* Y = (bf16*)((unsigned char*)a.outp() + DO_Y); float* ssa = (float*)(a.wsp() + WS_SSA);
    for (int u = bx; u < BATCH * NH * 16; u += G) {
        const int bh = u % 64, qt = (u / 64 + bh) % 16;
        attn_unit(Q, K, V, Y, ssa, lds, bh / NH, bh % NH, qt, wave, lane);
    }
}
}


namespace lru {
typedef short bf16x8 __attribute__((ext_vector_type(8)));
template <int CTRL> __device__ __forceinline__ float dpp_f(float v) { return __builtin_bit_cast(float, __builtin_amdgcn_update_dpp(0, __builtin_bit_cast(int, v), CTRL, 0xF, 0xF, true)); }
constexpr int WP = 64, NSTEP = SEQ / (8 * WP), XBUF = 8576  , WT = 2 * 8 * XBUF  , GRB = WT + 2048  ;
__device__ __forceinline__ void lru_item(const Args& a, LAS unsigned char* lds, int b, int cg, int wave, int lane) {
    const int g = cg >> 2, j0 = 16 * (cg & 3), ch0 = 16 * cg;
    const bf16* XR = (const bf16*)(a.wsp() + WS_PROJ) + 3 * PROJ_STRIDE + (size_t)b * SEQ * 512 + g * 64;
    const bf16* GR = (const bf16*)(a.wsp() + WS_PROJ) + 4 * PROJ_STRIDE + (size_t)b * SEQ * 512 + ch0;
    bf16* Y = (bf16*)((unsigned char*)a.outp() + DO_Y) + (size_t)b * SEQ * DM + 512 + ch0;
    float* ssl = (float*)(a.wsp() + WS_SSL) + (size_t)cg * NTOK + (size_t)b * SEQ;
    __syncthreads();
    const int c = lane & 15, pq = lane >> 4;
    bf16x8 wrf[4][2], wif[4][2];
    const int ch = ch0 + c;
    float rgb = a.inp(I_RGB)[ch], igb = a.inp(I_IGB)[ch];
    { const float* rw = a.inp(I_RGW) + (size_t)g * 4096 + j0 + c; const float* iw = a.inp(I_IGW) + (size_t)g * 4096 + j0 + c;
      const float* cwp = a.inp(I_CONVW) + g * 64; const float* cbp = a.inp(I_CONVB) + g * 64;
#pragma unroll
      for (int ks = 0; ks < 2; ++ks) { float wr_[8], wi_[8];
#pragma unroll
          for (int jj = 0; jj < 8; ++jj) { const int k = 32 * ks + 8 * pq + jj; wr_[jj] = rw[k * 64]; wi_[jj] = iw[k * 64]; }
#pragma unroll
          for (int j = 0; j < 4; ++j) { float tr[8], ti[8];
#pragma unroll
              for (int jj = 0; jj < 8; ++jj) { const float cwv = cwp[j * LRW + 32 * ks + 8 * pq + jj]; tr[jj] = cwv * wr_[jj]; ti[jj] = cwv * wi_[jj]; }
              wrf[j][ks] = att::pack8(tr); wif[j][ks] = att::pack8(ti); } }
      float sr = 0.f, si = 0.f;
#pragma unroll 1
      for (int k0 = 0; k0 < 64; k0 += 16) { float tr_[16], ti_[16], tb_[16];
#pragma unroll
          for (int k = 0; k < 16; ++k) { tb_[k] = cbp[k0 + k]; tr_[k] = rw[(k0 + k) * 64]; ti_[k] = iw[(k0 + k) * 64]; }
#pragma unroll
          for (int k = 0; k < 16; ++k) { sr += tb_[k] * tr_[k]; si += tb_[k] * ti_[k]; } }
      rgb += sr; igb += si; }
    float la2; { const float lam = a.inp(I_LAMBDA)[ch]; const float sp = fmaxf(-lam, 0.f) + log1pf(__expf(-fabsf(lam))); la2 = -8.0f * sp * 1.4426950408889634f; }
    float cwo[5];
#pragma unroll
    for (int jj = 0; jj < 4; ++jj) cwo[jj] = a.inp(I_CONVW)[jj * LRW + g * 64 + j0 + c];
    cwo[4] = a.inp(I_CONVB)[g * 64 + j0 + c];
    LAS unsigned char* xb = lds + wave * (2 * XBUF);
    LAS unsigned char* gb = lds + GRB + wave * 2048;
#define LRU_DMA(p0, buf) do { const bf16* s_ = XR + ((long)(p0) - 3 + (lane >> 3)) * 512 + 8 * (lane & 7); \
        _Pragma("unroll") for (int j_ = 0; j_ < 8; ++j_) glds16(s_ + (long)j_ * 8 * 512, lds_addr(xb + (buf) * XBUF + j_ * 1024)); \
        if (lane < 24) glds16(s_ + (long)8 * 8 * 512, lds_addr(xb + (buf) * XBUF + 8 * 1024)); } while (0)
#define LRU_DMA_GR(p0) do { const bf16* g_ = GR + (size_t)((p0) + (lane >> 1)) * 512 + 8 * (lane & 1); \
        glds16(g_, lds_addr(gb)); glds16(g_ + 32 * 512, lds_addr(gb + 1024)); } while (0)
    asm volatile("" :: "v"(wrf[0][0]), "v"(wrf[1][0]), "v"(wrf[2][0]), "v"(wrf[3][0]), "v"(wrf[0][1]), "v"(wrf[1][1]), "v"(wrf[2][1]), "v"(wrf[3][1]));
    asm volatile("" :: "v"(wif[0][0]), "v"(wif[1][0]), "v"(wif[2][0]), "v"(wif[3][0]), "v"(wif[0][1]), "v"(wif[1][1]), "v"(wif[2][1]), "v"(wif[3][1]));
    asm volatile("" :: "v"(cwo[0]), "v"(cwo[1]), "v"(cwo[2]), "v"(cwo[3]), "v"(cwo[4]), "v"(rgb), "v"(igb), "v"(la2));
    asm volatile("s_waitcnt vmcnt(0)" ::: "memory");
    float hc = 0.f;
    LRU_DMA(64 * wave, 0); LRU_DMA_GR(64 * wave);
    asm volatile("s_waitcnt vmcnt(0)" ::: "memory");
    if (wave == 0 && lane < 24) *(LAS u32x4*)(xb + lane * 16) = (u32x4){0u, 0u, 0u, 0u};
    asm volatile("s_waitcnt lgkmcnt(0)" ::: "memory");
    for (int st = 0; st < NSTEP; ++st) {
        const int buf = st & 1, p0 = st * (8 * WP) + WP * wave;
        if (st + 1 < NSTEP) LRU_DMA(p0 + 8 * WP, buf ^ 1);
        const LAS unsigned char* xs = xb + buf * XBUF;
        f32x4 rp[4], ip[4];
#pragma unroll
        for (int mt = 0; mt < 4; ++mt) { rp[mt] = (f32x4){0.f, 0.f, 0.f, 0.f}; ip[mt] = rp[mt]; }
#pragma unroll
        for (int mt = 0; mt < 4; ++mt) { const LAS unsigned char* ap = xs + (16 * (c >> 2) + 4 * mt + (c & 3)) * 128 + pq * 16;
            bf16x8 af[8];
#pragma unroll
            for (int q = 0; q < 8; ++q) af[q] = *(const LAS bf16x8*)(ap + (q >> 1) * 128 + (q & 1) * 64);
            asm volatile("" : "+v"(af[0]), "+v"(af[1]), "+v"(af[2]), "+v"(af[3]), "+v"(af[4]), "+v"(af[5]), "+v"(af[6]), "+v"(af[7]));
#pragma unroll
            for (int q = 0; q < 8; ++q) { rp[mt] = __builtin_amdgcn_mfma_f32_16x16x32_bf16(af[q], wrf[q >> 1][q & 1], rp[mt], 0, 0, 0); ip[mt] = __builtin_amdgcn_mfma_f32_16x16x32_bf16(af[q], wif[q >> 1][q & 1], ip[mt], 0, 0, 0); } }
        float av[16], bv[16]; float Al = 1.f, Hl = 0.f;
        { const LAS unsigned char* xo = xs + (16 * pq) * 128 + (j0 + c) * 2;
          unsigned xw[19];
#pragma unroll
          for (int q = 0; q < 19; ++q) xw[q] = *(const LAS bf16*)(xo + q * 128);
          asm volatile("" : "+v"(xw[0]), "+v"(xw[1]), "+v"(xw[2]), "+v"(xw[3]), "+v"(xw[4]), "+v"(xw[5]), "+v"(xw[6]), "+v"(xw[7]), "+v"(xw[8]), "+v"(xw[9]));
          asm volatile("" : "+v"(xw[10]), "+v"(xw[11]), "+v"(xw[12]), "+v"(xw[13]), "+v"(xw[14]), "+v"(xw[15]), "+v"(xw[16]), "+v"(xw[17]), "+v"(xw[18]));
#pragma unroll
          for (int idx = 0; idx < 16; ++idx) { const int mt = idx >> 2, r = idx & 3;
              const float w0 = __uint_as_float(xw[idx] << 16), w1 = __uint_as_float(xw[idx + 1] << 16), w2 = __uint_as_float(xw[idx + 2] << 16), w3 = __uint_as_float(xw[idx + 3] << 16);
              const float xcv = cwo[4] + (cwo[0] * w0 + cwo[1] * w1) + (cwo[2] * w2 + cwo[3] * w3);
              const float rr = __builtin_amdgcn_rcpf(1.f + __builtin_amdgcn_exp2f(-1.4426950408889634f * (rp[mt][r] + rgb))), ii = __builtin_amdgcn_rcpf(1.f + __builtin_amdgcn_exp2f(-1.4426950408889634f * (ip[mt][r] + igb)));
              const float aa = __builtin_amdgcn_exp2f(rr * la2);
              av[idx] = aa; bv[idx] = __builtin_amdgcn_sqrtf(fmaxf(1.f - aa * aa, 0.f)) * (ii * xcv);
              Hl = aa * Hl + bv[idx]; Al *= aa; } }
        float Ap = 1.f, Hp = 0.f;
#pragma unroll
        for (int k = 0; k < 3; ++k) { const float Ak = __shfl(Al, c + 16 * k), Hk = __shfl(Hl, c + 16 * k); if (k < pq) { Hp = Ak * Hp + Hk; Ap = Ap * Ak; } }
        typedef float f32x2 __attribute__((ext_vector_type(2)));
        if (pq == 3) *(LAS f32x2*)(lds + WT + ((buf * 8 + wave) * 16 + c) * 8) = (f32x2){Ap * Al, Al * Hp + Hl};
        asm volatile("s_waitcnt lgkmcnt(0)\n\ts_barrier" ::: "memory");
        if (st + 1 < NSTEP) asm volatile("s_waitcnt vmcnt(9)" ::: "memory"); else asm volatile("s_waitcnt vmcnt(0)" ::: "memory");
        float hin = hc;
        unsigned gw_[16];
#pragma unroll
        for (int q = 0; q < 16; ++q) gw_[q] = *(const LAS bf16*)(gb + (16 * pq + q) * 32 + c * 2);
        { f32x2 tw[8];
#pragma unroll
          for (int v = 0; v < 8; ++v) tw[v] = *(const LAS f32x2*)(lds + WT + ((buf * 8 + v) * 16 + c) * 8);
          asm volatile("" : "+v"(tw[0]), "+v"(tw[1]), "+v"(tw[2]), "+v"(tw[3]), "+v"(tw[4]), "+v"(tw[5]), "+v"(tw[6]), "+v"(tw[7]));
          asm volatile("" : "+v"(gw_[0]), "+v"(gw_[1]), "+v"(gw_[2]), "+v"(gw_[3]), "+v"(gw_[4]), "+v"(gw_[5]), "+v"(gw_[6]), "+v"(gw_[7]));
          asm volatile("" : "+v"(gw_[8]), "+v"(gw_[9]), "+v"(gw_[10]), "+v"(gw_[11]), "+v"(gw_[12]), "+v"(gw_[13]), "+v"(gw_[14]), "+v"(gw_[15]));
          float h = hc;
#pragma unroll
          for (int v = 0; v < 8; ++v) { if (v == wave) hin = h; h = tw[v].x * h + tw[v].y; }
          hc = h; }
        float h = Ap * hin + Hp;
        const size_t prow0 = (size_t)(p0 + 16 * pq); float smine = 0.f;
#pragma unroll
        for (int idx = 0; idx < 16; ++idx) {
            h = av[idx] * h + bv[idx];
            const float gr = __uint_as_float(gw_[idx] << 16);
            const float uu = 0.7978845608028654f * (gr + 0.044715f * gr * gr * gr);
            const float th = 1.f - 2.f * __builtin_amdgcn_rcpf(1.f + __builtin_amdgcn_exp2f(2.8853900817779268f * uu));
            const float y = h * (0.5f * gr * (1.f + th));
            Y[(prow0 + idx) * DM + c] = (bf16)f2bf(y);
            float s = y * y; s += dpp_f<0xB1>(s); s += dpp_f<0x4E>(s); s += dpp_f<0x141>(s); s += dpp_f<0x140>(s);
            if (c == idx) smine = s;
        }
        ssl[prow0 + c] = smine;
        if (st + 1 < NSTEP) { asm volatile("s_waitcnt lgkmcnt(0)" ::: "memory"); LRU_DMA_GR(p0 + 8 * WP); asm volatile("s_waitcnt vmcnt(16)" ::: "memory"); }
    }
#undef LRU_DMA
#undef LRU_DMA_GR
}
__device__ __forceinline__ void lru_phase(const Args& a, LAS unsigned char* lds, int wave, int lane, int G, int bx) {
    for (int it = bx; it < BATCH * 32; it += G) lru_item(a, lds, it / 32, it % 32, wave, lane);
    asm volatile("s_waitcnt vmcnt(0)" ::: "memory");
    __syncthreads();
}
}

constexpr int NPH = 9;
__device__ __forceinline__ Args kargs() {
    Args r{};
#if defined(__HIP_DEVICE_COMPILE__)
    static_assert(sizeof(Args) % 8 == 0, "Args is copied in 8-byte words");
    const __attribute__((address_space(4))) unsigned long long* q = (const __attribute__((address_space(4))) unsigned long long*)__builtin_amdgcn_kernarg_segment_ptr();
    unsigned long long* d = (unsigned long long*)&r;
#pragma unroll
    for (int i = 0; i < (int)(sizeof(Args) / 8); ++i) d[i] = q[i];
#endif
    return r;
}
__global__ void __launch_bounds__(NWAVES * 64, 2) fwd(Args args_unused) {
    extern __shared__ __attribute__((aligned(16))) unsigned char lds_[];
    LAS unsigned char* lds = (LAS unsigned char*)lds_;
    volatile LAS unsigned* MISC = (volatile LAS unsigned*)(lds + MISC_OFF);
    const int wave = __builtin_amdgcn_readfirstlane(threadIdx.x >> 6);
#define lane lane_id()
#define tid (wave * 64 + lane_id())
    const int G = gridDim.x; const int bx = blockIdx.x; const int vcu = (G % 8 == 0) ? (bx % 8) * (G / 8) + bx / 8 : bx;
    for (int u = threadIdx.x; u < (LDS_BYTES - LDSCTL_OFF) / 4; u += NWAVES * 64) ((LAS unsigned*)(lds + LDSCTL_OFF))[u] = 0u;
    __syncthreads();
    int lo, hi; unsigned* barw;
    { const Args a0 = kargs(); lo = a0.ph_lo; hi = a0.ph_hi; barw = (unsigned*)(a0.wsp() + WS_CTL) + CW_BAR + a0.li * XCD_BAR_WORDS; }
    const bool multi = (hi - lo) > 1;
    XcdBarrier bar; bar.bar = barw; bar.x = 0; bar.st = nullptr;
    if (multi) bar = xcd_barrier_post(barw, MISC + 8);
#define IN(k) (lo <= (k) && (k) < hi)
#define BOTH(k) (IN(k) && IN((k) + 1))
    if (IN(0)) { const Args args = kargs();     p0_adaln(args, lds, tid, G); if (BOTH(0)) xcd_barrier(bar, wave); }
    if (IN(1)) { const Args args = kargs();     p1_prep(args, lds, tid, lane, wave, vcu, G); if (BOTH(1)) xcd_barrier(bar, wave); }
    if (IN(2)) { const Args args = kargs();
        pg8::StaticOrder S; S.init(NTOK, DIN, G, bx, args.wsp() + WS_WINT, DM);
        pg8::EpiProj E{(bf16*)(args.wsp() + WS_PROJ)};
        pg8::gemm_phase<pg8::EpiProj, pg8::StaticOrder, true>(lds, args.wsp() + WS_XN, (unsigned)NTOK * DM * 2u, args.wsp() + WS_WINT, (unsigned)DIN * DM * 2u, DM * 2, S, E, wave);
        if (BOTH(2)) xcd_barrier(bar, wave);
    }
    if (IN(3)) { const Args args = kargs();
        att::attn_phase(args, lds, wave, lane, G, bx);
        asm volatile("s_waitcnt vmcnt(0)" ::: "memory"); __syncthreads();
        lru::lru_phase(args, lds, wave, lane, G, bx);
        if (BOTH(3)) xcd_barrier(bar, wave);
    }
    if (IN(4)) { const Args args = kargs();
        pg8::StaticOrder S; S.init(NTOK, DM, G, bx, args.wsp() + WS_WOUTT, DM);
        LAS float* rst = (LAS float*)(lds + TAB_OFF);
        { const float* ssa = (const float*)(args.wsp() + WS_SSA); const float* ssl = (const float*)(args.wsp() + WS_SSL);
          for (int ui = 0; ui < 8; ++ui) { pg8::Unit u; if (!S.next(ui, u)) break;
              const int row = tid & 255, which = tid >> 8; const size_t grow = (size_t)u.pm * 256 + row; float s = 0.f;
              if (which == 0) { const f32x4 p0 = *(const f32x4*)(ssa + grow * 8), p1 = *(const f32x4*)(ssa + grow * 8 + 4); s = ((p0.x + p0.y) + (p0.z + p0.w)) + ((p1.x + p1.y) + (p1.z + p1.w)); }
              else { for (int q = 0; q < 32; ++q) s += ssl[(size_t)q * NTOK + grow]; }
              rst[(ui * 256 + row) * 2 + which] = rsqrtf(s * (1.f / 512.f) + EPS); } }
        __syncthreads();
        pg8::EpiOut E{args.inp(I_X), (const float*)(args.wsp() + WS_MOD), (bf16*)(args.wsp() + WS_X1B), (float*)(args.wsp() + WS_SSX), rst};
        pg8::gemm_phase<pg8::EpiOut, pg8::StaticOrder, true>(lds, (const unsigned char*)args.outp() + DO_Y, (unsigned)NTOK * DM * 2u, args.wsp() + WS_WOUTT, (unsigned)DM * DM * 2u, DM * 2, S, E, wave);
        if (BOTH(4)) xcd_barrier(bar, wave);
    }
    if (IN(5)) { const Args args = kargs();     p5_router(args, lds, tid, lane, wave, G); if (BOTH(5)) xcd_barrier(bar, wave); }
    if (IN(6)) { const Args args = kargs();
        const pg8::MoeTables T = pg8::moe_tables(lds + TAB_OFF, (const unsigned*)(args.wsp() + WS_CTL) + CW_CNT, tid);
        pg8::MoeOrder S{(const char*)(args.wsp() + WS_WGU), 8, 2, T, bx % 8, bx / 8, G / 8, 0};
        S.load_entries((const int*)(args.wsp() + WS_LIST), nullptr, tid);
        pg8::EpiGU E{T.ent, args.inp(I_BG), args.inp(I_BU), args.wsp() + WS_ACT, (LAS const float*)(lds + BIAS_OFF)};
        pg8::gemm_phase<pg8::EpiGU, pg8::MoeOrder, true>(lds, (const unsigned char*)args.outp() + DO_H2, (unsigned)NTOK * DM, args.wsp() + WS_WGU, (unsigned)NE * 2u * DE * DM, DM, S, E, wave);
        if (BOTH(6)) xcd_barrier(bar, wave);
    }
    if (IN(7)) { const Args args = kargs();
        const pg8::MoeTables T = pg8::moe_tables(lds + TAB_OFF, (const unsigned*)(args.wsp() + WS_CTL) + CW_CNT, tid);
        pg8::MoeOrder S{(const char*)(args.wsp() + WS_WDT), 4, 0, T, bx % 8, bx / 8, G / 8, 1};
        S.load_entries((const int*)(args.wsp() + WS_LIST), (const float*)(args.wsp() + WS_PASG), tid);
        pg8::EpiDown E{T.ent, args.inp(I_BD), T.pw, (unsigned char*)args.outp(), (LAS const float*)(lds + BIAS_OFF)};
        pg8::gemm_phase<pg8::EpiDown, pg8::MoeOrder, true>(lds, args.wsp() + WS_ACT, (unsigned)NASG * DE, args.wsp() + WS_WDT, (unsigned)NE * DM * DE, DE, S, E, wave);
        if (BOTH(7)) xcd_barrier(bar, wave);
    }
    if (IN(8)) { const Args args = kargs();     p8_final(args, lds, lane, wave, vcu, G); }
#undef IN
#undef BOTH
#undef lane
#undef tid
}

extern "C" void kernel_launch(void* const* d_in, const int* in_sizes, int n_in, void* d_out, int out_size, void* d_ws, size_t ws_size, hipStream_t stream) {
    static int grid = 0;
    if (grid == 0) {
        if (n_in != 26 || out_size != NTOK * DM || ws_size < WS_END) { fprintf(stderr, "kernel_launch: unexpected shapes (n_in %d out %d ws %zu)\n", n_in, out_size, ws_size); grid = -1; return; }
        int dev = 0, cus = 0;
        if (hipGetDevice(&dev) != hipSuccess || hipDeviceGetAttribute(&cus, hipDeviceAttributeMultiprocessorCount, dev) != hipSuccess) { grid = -1; return; }
        if (hipFuncSetAttribute((const void*)fwd, hipFuncAttributeMaxDynamicSharedMemorySize, LDS_BYTES) != hipSuccess) { grid = -1; return; }
        int per_cu = 0;
        (void)hipOccupancyMaxActiveBlocksPerMultiprocessor(&per_cu, (const void*)fwd, NWAVES * 64, LDS_BYTES);
        (void)hipGetLastError();
        grid = cus;
    }
    if (grid < 0) return;
    (void)hipMemsetAsync((char*)d_ws + WS_CTL, 0, CTL_ZERO_BYTES, stream);
    Args a{};
    for (int i = 0; i < 26; ++i) a.in[i] = (KGAS const float*)d_in[i];
    a.out = (KGAS float*)d_out; a.ws = (KGAS unsigned char*)d_ws;
    a.ph_lo = 0; a.ph_hi = NPH; a.li = 0; a.pad = 0;
    hipLaunchKernelGGL(fwd, dim3(grid), dim3(NWAVES * 64), LDS_BYTES, stream, a);
}
```
